# Optimizing an MI355X kernel written in HIP

```python
import math
import jax, jax.numpy as jnp
from jax import lax
import numpy as np

D_MODEL = 1024
BATCH = 16
SEQ = 4096
DEPTH = 1

HEAD_DIM = 64
SB_HEADS = 8
SB_WIDTH = SB_HEADS * HEAD_DIM
RG_BLOCKS = 4
RG_BLOCK_DIM = 64
RG_WIDTH = RG_BLOCKS * RG_BLOCK_DIM
CA_HEADS = 4
CA_WIDTH = CA_HEADS * HEAD_DIM
D_MIX = SB_WIDTH + RG_WIDTH + CA_WIDTH
D_IN = 3 * SB_WIDTH + 2 * RG_WIDTH + CA_WIDTH
IN_SPLITS = (SB_WIDTH, 2 * SB_WIDTH, 3 * SB_WIDTH, 3 * SB_WIDTH + RG_WIDTH, 3 * SB_WIDTH + 2 * RG_WIDTH)
MEM_LEN = 256
CONV_WIDTH = 4
LRU_C = 8.0
SB_BLOCK = 128
N_EXPERTS = 64
TOP_K = 8
N_GROUPS = 8
TOPK_GROUPS = 4
D_EXPERT = 256
D_SHARED = 256
ROUTED_SCALE = 2.5
RMS_EPS = 1e-6

kernel_name = 'hybrid_stickbreak_rglru_memxattn_moe'


def rms_norm(x, g):
    xf = x.astype(jnp.float32)
    y = xf * lax.rsqrt(jnp.mean(xf * xf, axis=-1, keepdims=True) + RMS_EPS)
    return (y * g.astype(jnp.float32)).astype(x.dtype)


def split_heads(t, n_heads):
    b, s, _ = t.shape
    return t.reshape(b, s, n_heads, HEAD_DIM).transpose(0, 2, 1, 3)


def merge_heads(t):
    b, n, s, d = t.shape
    return t.transpose(0, 2, 1, 3).reshape(b, s, n * d)


def stick_breaking_attention(q, k, v):
    b, h, s, d = q.shape
    n_blocks = s // SB_BLOCK
    scale = 1.0 / math.sqrt(d)
    kf = k.astype(jnp.float32)
    vf = v.astype(jnp.float32)
    q_blocks = q.reshape(b, h, n_blocks, SB_BLOCK, d).transpose(2, 0, 1, 3, 4)
    key_pos = jnp.arange(s)

    def one_block(args):
        q_blk, blk = args
        z = jnp.einsum('bhqd,bhkd->bhqk', q_blk.astype(jnp.float32), kf) * scale
        query_pos = blk * SB_BLOCK + jnp.arange(SB_BLOCK)
        strict = key_pos[None, :] < query_pos[:, None]
        log_beta = jax.nn.log_sigmoid(z)
        log_not = jnp.where(strict, jax.nn.log_sigmoid(-z), 0.0)
        between = lax.cumsum(log_not, axis=3, reverse=True) - log_not
        w = jnp.where(strict, jnp.exp(log_beta + between), 0.0)
        return jnp.einsum('bhqk,bhkd->bhqd', w, vf)

    out = lax.map(one_block, (q_blocks, jnp.arange(n_blocks)))
    return out.transpose(1, 2, 0, 3, 4).reshape(b, h, s, d).astype(q.dtype)


def causal_depthwise_conv(x, w, bias):
    s = x.shape[1]
    xp = jnp.pad(x, ((0, 0), (CONV_WIDTH - 1, 0), (0, 0)))
    out = bias
    for tap in range(CONV_WIDTH):
        out = out + w[tap] * xp[:, tap:tap + s]
    return out


def rg_lru(x, w_rgate, b_rgate, w_igate, b_igate, lru_lambda):
    bsz, s, c = x.shape
    xf = x.astype(jnp.float32)
    xb = xf.reshape(bsz, s, RG_BLOCKS, RG_BLOCK_DIM)
    r = jax.nn.sigmoid(jnp.einsum('bsnc,ncd->bsnd', xb, w_rgate.astype(jnp.float32)).reshape(bsz, s, c)
                       + b_rgate.astype(jnp.float32))
    i = jax.nn.sigmoid(jnp.einsum('bsnc,ncd->bsnd', xb, w_igate.astype(jnp.float32)).reshape(bsz, s, c)
                       + b_igate.astype(jnp.float32))
    log_a = -LRU_C * r * jax.nn.softplus(-lru_lambda.astype(jnp.float32))
    a = jnp.exp(log_a)
    u = jnp.sqrt(-jnp.expm1(2.0 * log_a)) * (i * xf)

    def combine(left, right):
        a_l, h_l = left
        a_r, h_r = right
        return a_l * a_r, a_r * h_l + h_r

    _, h = lax.associative_scan(combine, (a, u), axis=1)
    return h


def memory_cross_attention(q, mem, norm_mem_g, w_mem_kv, q_norm_g, k_norm_g):
    mem_n = rms_norm(mem, norm_mem_g)
    k, v = jnp.split(mem_n @ w_mem_kv, 2, axis=-1)
    qh = rms_norm(split_heads(q, CA_HEADS), q_norm_g)
    kh = rms_norm(split_heads(k, CA_HEADS), k_norm_g)
    vh = split_heads(v, CA_HEADS)
    z = jnp.einsum('bhsd,bhmd->bhsm', qh.astype(jnp.float32), kh.astype(jnp.float32)) / math.sqrt(HEAD_DIM)
    p = jax.nn.softmax(z, axis=-1)
    o = jnp.einsum('bhsm,bhmd->bhsd', p, vh.astype(jnp.float32))
    return merge_heads(o).astype(q.dtype)


def hybrid_mixer(x, mem, norm_mix_g, norm_mem_g, w_in, conv_w, conv_b, w_rgate, b_rgate, w_igate,
                 b_igate, lru_lambda, w_mem_kv, q_norm_g, k_norm_g, g_out_sb, g_out_rg, g_out_ca, w_out):
    h = rms_norm(x, norm_mix_g)
    proj = h @ w_in
    q_sb, k_sb, v_sb, x_rg, gate_rg, q_ca = jnp.split(proj, IN_SPLITS, axis=-1)
    o_sb = merge_heads(stick_breaking_attention(split_heads(q_sb, SB_HEADS), split_heads(k_sb, SB_HEADS),
                                                split_heads(v_sb, SB_HEADS)))
    xc = causal_depthwise_conv(x_rg, conv_w, conv_b)
    hr = rg_lru(xc, w_rgate, b_rgate, w_igate, b_igate, lru_lambda)
    o_rg = (jax.nn.gelu(gate_rg.astype(jnp.float32)) * hr).astype(x.dtype)
    o_ca = memory_cross_attention(q_ca, mem, norm_mem_g, w_mem_kv, q_norm_g, k_norm_g)
    y = jnp.concatenate([rms_norm(o_sb, g_out_sb), rms_norm(o_rg, g_out_rg), rms_norm(o_ca, g_out_ca)], axis=-1)
    return y @ w_out


def moe_ffn(xn, w_router, router_bias, w_gate_e, w_up_e, w_down_e, w_gate_sh, w_up_sh, w_down_sh):
    bsz, s, d = xn.shape
    t = xn.reshape(bsz * s, d)
    n_tok = t.shape[0]
    scores = jax.nn.sigmoid(t.astype(jnp.float32) @ w_router.astype(jnp.float32))
    choice = scores + router_bias.astype(jnp.float32)
    grp = choice.reshape(n_tok, N_GROUPS, N_EXPERTS // N_GROUPS)
    grp_score = lax.top_k(grp, 2)[0].sum(axis=-1)
    _, gidx = lax.top_k(grp_score, TOPK_GROUPS)
    gmask = jax.nn.one_hot(gidx, N_GROUPS, dtype=jnp.float32).sum(axis=1) > 0
    emask = jnp.repeat(gmask, N_EXPERTS // N_GROUPS, axis=1)
    _, eidx = lax.top_k(jnp.where(emask, choice, -jnp.inf), TOP_K)
    w = jnp.take_along_axis(scores, eidx, axis=1)
    w = w / (w.sum(axis=-1, keepdims=True) + 1e-20) * ROUTED_SCALE
    rows = jnp.arange(n_tok)[:, None]
    gates = jnp.zeros((n_tok, N_EXPERTS), jnp.float32).at[rows, eidx].set(w)

    def add_expert(acc, params):
        wg, wu, wd, g = params
        hid = jax.nn.silu(t @ wg) * (t @ wu)
        return acc + g[:, None] * (hid @ wd).astype(jnp.float32), None

    routed, _ = lax.scan(add_expert, jnp.zeros((n_tok, d), jnp.float32),
                         (w_gate_e, w_up_e, w_down_e, gates.T))
    shared = (jax.nn.silu(t @ w_gate_sh) * (t @ w_up_sh)) @ w_down_sh
    return (routed + shared.astype(jnp.float32)).reshape(bsz, s, d).astype(xn.dtype)


def setup_inputs(seed: int = 0) -> dict:
    key = jax.random.key(seed)
    ks = jax.random.split(key, 28)
    f = jnp.float32
    L = DEPTH

    def nrm(k, shape, fan_in):
        return jax.random.normal(k, shape, f) * fan_in ** -0.5

    def gain(k, shape):
        return 1.0 + 0.02 * jax.random.normal(k, shape, f)

    def small(k, shape):
        return 0.02 * jax.random.normal(k, shape, f)

    u = jax.random.uniform(ks[11], (L, RG_WIDTH), f, 0.9, 0.999)
    a0 = u ** (1.0 / LRU_C)
    lru_lambda = jnp.log(a0) - jnp.log1p(-a0)
    return {
        'x': jax.random.normal(ks[0], (BATCH, SEQ, D_MODEL), f),
        'mem': jax.random.normal(ks[1], (BATCH, MEM_LEN, D_MODEL), f),
        'norm_mix_g': gain(ks[2], (L, D_MODEL)),
        'norm_mem_g': gain(ks[3], (L, D_MODEL)),
        'w_in': nrm(ks[4], (L, D_MODEL, D_IN), D_MODEL),
        'conv_w': nrm(ks[5], (L, CONV_WIDTH, RG_WIDTH), CONV_WIDTH),
        'conv_b': small(ks[6], (L, RG_WIDTH)),
        'w_rgate': nrm(ks[7], (L, RG_BLOCKS, RG_BLOCK_DIM, RG_BLOCK_DIM), RG_BLOCK_DIM),
        'b_rgate': small(ks[8], (L, RG_WIDTH)),
        'w_igate': nrm(ks[9], (L, RG_BLOCKS, RG_BLOCK_DIM, RG_BLOCK_DIM), RG_BLOCK_DIM),
        'b_igate': small(ks[10], (L, RG_WIDTH)),
        'lru_lambda': lru_lambda,
        'w_mem_kv': nrm(ks[12], (L, D_MODEL, 2 * CA_WIDTH), D_MODEL),
        'q_norm_g': gain(ks[13], (L, HEAD_DIM)),
        'k_norm_g': gain(ks[14], (L, HEAD_DIM)),
        'g_out_sb': gain(ks[15], (L, SB_WIDTH)),
        'g_out_rg': gain(ks[16], (L, RG_WIDTH)),
        'g_out_ca': gain(ks[17], (L, CA_WIDTH)),
        'w_out': nrm(ks[18], (L, D_MIX, D_MODEL), D_MIX),
        'norm_ffn_g': gain(ks[19], (L, D_MODEL)),
        'w_router': nrm(ks[20], (L, D_MODEL, N_EXPERTS), D_MODEL),
        'router_bias': 0.01 * jax.random.normal(ks[21], (L, N_EXPERTS), f),
        'w_gate_e': nrm(ks[22], (L, N_EXPERTS, D_MODEL, D_EXPERT), D_MODEL),
        'w_up_e': nrm(ks[23], (L, N_EXPERTS, D_MODEL, D_EXPERT), D_MODEL),
        'w_down_e': nrm(ks[24], (L, N_EXPERTS, D_EXPERT, D_MODEL), D_EXPERT),
        'w_gate_sh': nrm(ks[25], (L, D_MODEL, D_SHARED), D_MODEL),
        'w_up_sh': nrm(ks[26], (L, D_MODEL, D_SHARED), D_MODEL),
        'w_down_sh': nrm(ks[27], (L, D_SHARED, D_MODEL), D_SHARED),
    }


def reference(x, mem, norm_mix_g, norm_mem_g, w_in, conv_w, conv_b, w_rgate, b_rgate, w_igate, b_igate,
              lru_lambda, w_mem_kv, q_norm_g, k_norm_g, g_out_sb, g_out_rg, g_out_ca, w_out, norm_ffn_g,
              w_router, router_bias, w_gate_e, w_up_e, w_down_e, w_gate_sh, w_up_sh, w_down_sh):
    for layer in range(DEPTH):
        x = x + hybrid_mixer(x, mem, norm_mix_g[layer], norm_mem_g[layer], w_in[layer], conv_w[layer],
                             conv_b[layer], w_rgate[layer], b_rgate[layer], w_igate[layer], b_igate[layer],
                             lru_lambda[layer], w_mem_kv[layer], q_norm_g[layer], k_norm_g[layer],
                             g_out_sb[layer], g_out_rg[layer], g_out_ca[layer], w_out[layer])
        x = x + moe_ffn(rms_norm(x, norm_ffn_g[layer]), w_router[layer], router_bias[layer], w_gate_e[layer],
                        w_up_e[layer], w_down_e[layer], w_gate_sh[layer], w_up_sh[layer], w_down_sh[layer])
    return x
```

```cpp
#include <hip/hip_runtime.h>
#include <cstdio>
#include <cstdint>

#ifndef MK_N_LAUNCHES
#define MK_N_LAUNCHES 9
#endif

#define DI __device__ __forceinline__
#define LAS __attribute__((address_space(3)))
#define GAS __attribute__((address_space(1)))
typedef unsigned short bf16_t;
typedef short bf16x8 __attribute__((ext_vector_type(8)));
typedef float f32x4 __attribute__((ext_vector_type(4)));
typedef float f32x2 __attribute__((ext_vector_type(2)));
typedef float f32x16 __attribute__((ext_vector_type(16)));
typedef unsigned u32x4 __attribute__((ext_vector_type(4)));
typedef unsigned u32x2 __attribute__((ext_vector_type(2)));
typedef __bf16 bf16x2_t __attribute__((ext_vector_type(2)));
typedef GAS unsigned gu32;
#define RLX_AGENT __ATOMIC_RELAXED, __HIP_MEMORY_SCOPE_AGENT

constexpr int T_TOK = 65536, DM = 1024, DIN = 2304, SEQ = 4096, NBATCH = 16, MEMLEN = 256, NMEM = NBATCH * MEMLEN;
constexpr int NEXP = 64, TOPK = 8, DEXP = 256, CAP = 65536;
constexpr float RMS_EPS = 1e-6f;
constexpr int COL_Q = 0, COL_K = 512, COL_V = 1024, COL_XRG = 1536, COL_GRG = 1792, COL_QCA = 2048;
constexpr int NPHASE = 9;

constexpr size_t MiB = 1u << 20;
constexpr size_t WS_CTL = 0, CTL_ZERO_BYTES = 1 * MiB;
constexpr size_t WS_RINV1 = 1 * MiB, WS_RINV2 = 1 * MiB + 256 * 1024, WS_SEG = 2 * MiB, WS_WRHI = 3 * MiB, WS_WRLO = 3 * MiB + 128 * 1024, WS_RGW = 3 * MiB + 256 * 1024, WS_GATEW = 4 * MiB;
constexpr size_t WS_W1T = 8 * MiB, WS_W2T = 13 * MiB, WS_WMT = 15 * MiB, WS_WGU = 16 * MiB, WS_WD = 81 * MiB;
constexpr size_t WS_MEMN = 114 * MiB, WS_KVM = 122 * MiB, WS_EXPL = 128 * MiB;
constexpr size_t WS_PROJ = 144 * MiB, WS_HID = 144 * MiB;
constexpr size_t WS_XB = 440 * MiB, WS_X1B = 440 * MiB, WS_O = 568 * MiB, WS_Y8 = 440 * MiB, WS_END = 952 * MiB;
constexpr int CW_TMO = 0, CW_BAR = 4096, CW_CNT = 16384;

constexpr int RING_BYTES = 131072, LDSCTL_OFF = RING_BYTES, MISC_OFF = LDSCTL_OFF + 320, TOFF_OFF = LDSCTL_OFF + 1024, LCNT_OFF = TOFF_OFF + 512, TAB_OFF = LDSCTL_OFF + 2048;
constexpr int LDS_BYTES = 147456;

DI unsigned pk2(float lo, float hi) { f32x2 v = {lo, hi}; return __builtin_bit_cast(unsigned, __builtin_convertvector(v, bf16x2_t)); }
DI float bf2f(unsigned short b) { return __uint_as_float((unsigned)b << 16); }
DI bf16_t f2bf(float f) { return (bf16_t)(pk2(f, 0.f) & 0xffffu); }
DI float bflo(unsigned w) { return __uint_as_float(w << 16); }
DI float bfhi(unsigned w) { return __uint_as_float(w & 0xffff0000u); }
DI float wave_sum(float v) {
#pragma unroll
    for (int o = 1; o < 64; o <<= 1) v += __shfl_xor(v, o);
    return v;
}
DI int crow(int r, int h) { return (r & 3) + 8 * (r >> 2) + 4 * h; }
DI float sigmoidf_(float v) { return 1.f / (1.f + __expf(-v)); }
#define MFMA32(a, b, c) __builtin_amdgcn_mfma_f32_32x32x16_bf16((a), (b), (c), 0, 0, 0)
#define MFMA16(a, b, c) __builtin_amdgcn_mfma_f32_16x16x32_bf16((a), (b), (c), 0, 0, 0)
#define LDS_WAIT() asm volatile("s_waitcnt lgkmcnt(0)" ::: "memory")
#define VM_WAIT() asm volatile("s_waitcnt vmcnt(0)" ::: "memory")

#define XB_TMO      128
#define XB_XCNT(j)  (256  + 64 * (j))
#define XB_XSUB(j)  (1280 + 64 * (j))
#define XB_XGEN(j)  (2304 + 64 * (j))
#define XB_TOP      3328
#define XB_TOPGEN   3392
#define XCD_BAR_WORDS 3456
#define XB_SPIN_CAP (1u << 18)
DI unsigned xb_ld(unsigned* p)              { return __hip_atomic_load(p, __ATOMIC_RELAXED, __HIP_MEMORY_SCOPE_AGENT); }
DI unsigned xb_add(unsigned* p, unsigned v) { return __hip_atomic_fetch_add(p, v, __ATOMIC_RELAXED, __HIP_MEMORY_SCOPE_AGENT); }
DI unsigned xb_xcc_id() { return (unsigned)__builtin_amdgcn_s_getreg((3 << 11) | 20) & 0xFu; }
#define XB_SPIN(cond, bar) do { unsigned _sp = 0; while (cond) { __builtin_amdgcn_s_sleep(1); \
    if ((++_sp & 255u) == 0u) { if (xb_ld(&(bar)[XB_TMO])) break; if (_sp > XB_SPIN_CAP) { atomicAdd(&(bar)[XB_TMO], 1u); break; } } } } while (0)
struct XcdBarrier { unsigned* bar; unsigned x; volatile LAS unsigned* st; };
DI XcdBarrier xcd_barrier_post(unsigned* bar, volatile LAS unsigned* st) {
    XcdBarrier b; b.bar = bar; b.x = xb_xcc_id(); b.st = st;
    if (threadIdx.x == 0) (void)xb_add(&bar[XB_XCNT(b.x)], 1u);
    return b;
}
DI void xcd_barrier_complete(unsigned* bar, unsigned x, unsigned& nloc, unsigned& nx) {
    const unsigned G = gridDim.x * gridDim.y * gridDim.z;
    unsigned sum, cnt, mine, sp = 0u;
    for (;;) {
        sum = 0u; cnt = 0u; mine = 0u;
#pragma unroll
        for (unsigned j = 0; j < 16; ++j) { const unsigned c = xb_ld(&bar[XB_XCNT(j)]); sum += c; cnt += (c > 0u) ? 1u : 0u; mine = (j == x) ? c : mine; }
        if (sum == G) break;
        __builtin_amdgcn_s_sleep(1);
        if ((++sp & 255u) == 0u) { if (xb_ld(&bar[XB_TMO])) break; if (sp > XB_SPIN_CAP) { atomicAdd(&bar[XB_TMO], 1u); break; } }
    }
    nloc = mine > 0u ? mine : 1u; nx = cnt > 0u ? cnt : 1u;
}
DI void xcd_barrier(const XcdBarrier& b) {
    asm volatile("s_waitcnt vmcnt(0)" ::: "memory");
    __syncthreads();
    if (threadIdx.x == 0) {
        unsigned* bar = b.bar;
        __builtin_amdgcn_s_waitcnt(0);
        unsigned nloc = b.st[0], nx = b.st[1];
        if (nloc == 0u) { xcd_barrier_complete(bar, b.x, nloc, nx); b.st[0] = nloc; b.st[1] = nx; }
        const unsigned old = xb_add(&bar[XB_XSUB(b.x)], 1u);
        const unsigned gen = old / nloc;
        if (old + 1u == (gen + 1u) * nloc) {
            __builtin_amdgcn_fence(__ATOMIC_RELEASE, "agent");
            asm volatile("s_waitcnt vmcnt(0)" ::: "memory");
            const unsigned og = xb_add(&bar[XB_TOP], 1u);
            const unsigned tg = og / nx;
            if (og + 1u == (tg + 1u) * nx) xb_add(&bar[XB_TOPGEN], 1u);
            else XB_SPIN(xb_ld(&bar[XB_TOPGEN]) == tg, bar);
            __builtin_amdgcn_fence(__ATOMIC_ACQUIRE, "agent");
            xb_add(&bar[XB_XGEN(b.x)], 1u);
            asm volatile("s_waitcnt vmcnt(0)" ::: "memory");
        } else {
            XB_SPIN(xb_ld(&bar[XB_XGEN(b.x)]) == gen, bar);
            __builtin_amdgcn_fence(__ATOMIC_ACQUIRE, "agent");
            asm volatile("s_waitcnt vmcnt(0)" ::: "memory");
        }
    }
    __syncthreads();
}

namespace pg8 {
constexpr int BM = 256, BK = 64, HALF = 128, HTB = HALF * BK * 2, STAGE_BYTES = 8 * HTB, NXCD = 8, WGM = 8;
__host__ __device__ __forceinline__ int lds_byte(int r, int c) { const int st = (r >> 4) * 2 + (c >> 5), rr = r & 15, cc = c & 31, ob = rr * 64 + cc * 2; return st * 1024 + (ob ^ (((ob >> 9) & 1) << 5)); }
__host__ __device__ __forceinline__ void stage_rc(int b, int& R, int& C) { const int st = b / 1024, sb = b % 1024, swz = sb ^ (((sb >> 9) & 1) << 5); R = (st >> 1) * 16 + swz / 64; C = (st & 1) * 32 + (swz % 64) / 2; }
__host__ __device__ __forceinline__ int perm32(int rho) { const int n = rho >> 4, i = rho & 15; return 8 * (i >> 2) + 4 * n + (i & 3); }

template <class Epi, class Sched>
DI void gemm_phase(LAS unsigned char* lds, LAS unsigned* tab  , const char* Abase, const int K, const Sched& S, const Epi& E) {
    typedef typename Sched::Unit Unit;
    const int tid = threadIdx.x, wid = __builtin_amdgcn_readfirstlane(tid >> 6), lane = tid & 63, wr = wid >> 2, wc = wid & 3, fr = lane & 15, fq = lane >> 4;
    const int nt = K / BK;
    int Rr[2]; unsigned Cc[2], voffB[2];
#pragma unroll
    for (int i = 0; i < 2; ++i) { int R, C; stage_rc(tid * 16 + i * 8192, R, C); const int Rb = Epi::PERM ? ((R & ~31) + perm32(R & 31)) : R;
        Rr[i] = R; Cc[i] = (unsigned)C * 2u; voffB[i] = (unsigned)(Rb * K + C) * 2u; }
    const size_t kstep = (size_t)(BK * 2);
    const size_t hstepB = (size_t)HALF * K * 2;
    const unsigned ldsw = (unsigned)wid * 1024u;
    const int aoff = lds_byte(wr * 64 + fr, fq * 8), boff = lds_byte(wc * 32 + fr, fq * 8);
#define PG8_SA(b, h) (((b) * 2 + (h)) * HTB)
#define PG8_SB(b, h) ((4 + (b) * 2 + (h)) * HTB)
#define PG8_STAGE_B(bufoff, gbase) do { _Pragma("unroll") for (int _i = 0; _i < 2; ++_i) \
        __builtin_amdgcn_global_load_lds((const unsigned*)((const char*)(gbase) + voffB[_i]), (LAS unsigned*)(lds + (bufoff) + ldsw + _i * 8192), 16, 0, 0); } while (0)
#define PG8_STAGE_A(bufoff, slot, h, kb) do { _Pragma("unroll") for (int _i = 0; _i < 2; ++_i) \
        __builtin_amdgcn_global_load_lds((const unsigned*)(Abase + (size_t)(tab[(slot) * 256 + (h) * HALF + Rr[_i]] + Cc[_i]) + (size_t)(kb)), (LAS unsigned*)(lds + (bufoff) + ldsw + _i * 8192), 16, 0, 0); } while (0)
#define PG8_FILL(slot, unit) do { if (tid < 256) tab[(slot) * 256 + tid] = S.arow(unit, tid); } while (0)
#define PG8_LDA(dst, b, h) do { _Pragma("unroll") for (int m = 0; m < 4; ++m) _Pragma("unroll") for (int k = 0; k < 2; ++k) dst[m][k] = *(const LAS bf16x8*)(lds + PG8_SA(b, h) + aoff + m * 2048 + k * 1024); } while (0)
#define PG8_LDB(dst, b, h) do { _Pragma("unroll") for (int n = 0; n < 2; ++n) _Pragma("unroll") for (int k = 0; k < 2; ++k) dst[n][k] = *(const LAS bf16x8*)(lds + PG8_SB(b, h) + boff + n * 2048 + k * 1024); } while (0)
#define PG8_MMA(ai, bj, At, Bt) do { __builtin_amdgcn_s_setprio(1); _Pragma("unroll") for (int m = 0; m < 4; ++m) _Pragma("unroll") for (int n = 0; n < 2; ++n) _Pragma("unroll") for (int k = 0; k < 2; ++k) \
        acc[ai][bj][m][n] = __builtin_amdgcn_mfma_f32_16x16x32_bf16(Bt[n][k], At[m][k], acc[ai][bj][m][n], 0, 0, 0); __builtin_amdgcn_s_setprio(0); } while (0)
#define PG8_WAIT_V(n) asm volatile("s_waitcnt vmcnt(" #n ")" ::: "memory")
#define PG8_WAIT_L(n) asm volatile("s_waitcnt lgkmcnt(" #n ")" ::: "memory")
#define PG8_BAR __builtin_amdgcn_s_barrier()
#define PG8_SCHED __builtin_amdgcn_sched_barrier(0)
    Unit cur, nxt; int ui = 0;
    if (!S.next(0, cur)) return;
    f32x4 acc[2][2][4][2];
#pragma unroll
    for (int a = 0; a < 2; ++a)
#pragma unroll
        for (int b = 0; b < 2; ++b)
#pragma unroll
            for (int m = 0; m < 4; ++m)
#pragma unroll
                for (int n = 0; n < 2; ++n) acc[a][b][m][n] = (f32x4){0.f, 0.f, 0.f, 0.f};
    bf16x8 At[4][2], B0[2][2], B1[2][2];
    const char* cB = S.bbase(cur);
    int cs = 0;
    PG8_FILL(0, cur);
    PG8_WAIT_L(0); PG8_BAR; asm volatile("" ::: "memory");
    PG8_STAGE_B(PG8_SB(0, 0), cB); PG8_STAGE_B(PG8_SB(0, 1), cB + hstepB); PG8_STAGE_A(PG8_SA(0, 0), cs, 0, 0); PG8_STAGE_A(PG8_SA(0, 1), cs, 1, 0);
    if (wr == 1) PG8_BAR;
    PG8_WAIT_V(2); PG8_BAR;
    PG8_STAGE_B(PG8_SB(1, 0), cB + kstep); PG8_STAGE_A(PG8_SA(1, 0), cs, 0, kstep); PG8_STAGE_B(PG8_SB(1, 1), cB + hstepB + kstep);
    PG8_WAIT_V(6); PG8_BAR;
    for (;;) {
        const bool has_next = S.next(ui + 1, nxt);
        const char* nB = has_next ? S.bbase(nxt) : cB;
        const int ns = has_next ? (cs ^ 1) : cs;
        if (has_next) PG8_FILL(ns, nxt);
        for (int t = 0; t < nt; t += 2) {
            const bool last = (t == nt - 2);
            const size_t k1 = (size_t)(t + 1) * kstep;
            const int v2 = last ? ns : cs;
            const size_t k2 = last ? (size_t)0 : (size_t)(t + 2) * kstep, k3 = k2 + kstep;
            const char* b2 = last ? nB : cB + (size_t)(t + 2) * kstep; const char* b3 = b2 + kstep;
            PG8_LDB(B0, 0, 0); PG8_LDB(B1, 0, 1); PG8_SCHED; PG8_LDA(At, 0, 0); PG8_STAGE_A(PG8_SA(1, 1), cs, 1, k1);
            PG8_WAIT_V(8); PG8_WAIT_L(0); PG8_BAR; PG8_MMA(0, 0, At, B0); PG8_MMA(0, 1, At, B1); PG8_BAR; PG8_SCHED;
            PG8_LDA(At, 0, 1); PG8_STAGE_B(PG8_SB(0, 0), b2); PG8_STAGE_B(PG8_SB(0, 1), b2 + hstepB); PG8_STAGE_A(PG8_SA(0, 0), v2, 0, k2);
            PG8_WAIT_V(8); PG8_WAIT_L(0); PG8_BAR; PG8_MMA(1, 0, At, B0); PG8_MMA(1, 1, At, B1); PG8_BAR; PG8_SCHED;
            PG8_LDB(B0, 1, 0); PG8_LDB(B1, 1, 1); PG8_SCHED; PG8_LDA(At, 1, 0); PG8_STAGE_A(PG8_SA(0, 1), v2, 1, k2);
            PG8_WAIT_V(8); PG8_WAIT_L(0); PG8_BAR; PG8_MMA(0, 0, At, B0); PG8_MMA(0, 1, At, B1); PG8_BAR; PG8_SCHED;
            PG8_LDA(At, 1, 1); PG8_STAGE_B(PG8_SB(1, 0), b3); PG8_STAGE_B(PG8_SB(1, 1), b3 + hstepB); PG8_STAGE_A(PG8_SA(1, 0), v2, 0, k3);
            PG8_WAIT_V(8); PG8_WAIT_L(0); PG8_BAR; PG8_MMA(1, 0, At, B0); PG8_MMA(1, 1, At, B1); PG8_BAR; PG8_SCHED;
        }
        if (wr == 0) PG8_BAR;
        E(acc, cur, wr, wc, fr, fq);
        if (!has_next) break;
#pragma unroll
        for (int a = 0; a < 2; ++a)
#pragma unroll
            for (int b = 0; b < 2; ++b)
#pragma unroll
                for (int m = 0; m < 4; ++m)
#pragma unroll
                    for (int n = 0; n < 2; ++n) acc[a][b][m][n] = (f32x4){0.f, 0.f, 0.f, 0.f};
        cur = nxt; cB = nB; cs = ns; ++ui;
        if (wr == 1) PG8_BAR;
    }
    PG8_WAIT_V(0);
    PG8_BAR;
#undef PG8_SA
#undef PG8_SB
#undef PG8_STAGE_A
#undef PG8_FILL
#undef PG8_STAGE_B
#undef PG8_LDA
#undef PG8_LDB
#undef PG8_MMA
#undef PG8_WAIT_V
#undef PG8_WAIT_L
#undef PG8_BAR
#undef PG8_SCHED
}

struct SchedStatic {
    struct Unit { int pm, pn; };
    int nM, nN, nwg, G, c, K; const char* Bt;
    DI void init(int M, int N, int K_, int G_, int c_, const void* Bt_) { nM = M / BM; nN = N / BM; nwg = nM * nN; G = G_; c = c_; K = K_; Bt = (const char*)Bt_; }
    DI bool next(int i, Unit& u) const {
        const long L = (long)i * G + c; if (L >= nwg) return false;
        int wgid = (int)L; { const int q = nwg / NXCD, r = nwg % NXCD, xcd = wgid % NXCD, off = wgid / NXCD; wgid = (xcd < r ? xcd * (q + 1) : r * (q + 1) + (xcd - r) * q) + off; }
        const int nig = WGM * nN, gid = wgid / nig, fm = gid * WGM, gsz = (nM - fm) < WGM ? (nM - fm) : WGM;
        u.pm = fm + ((wgid % nig) % gsz); u.pn = (wgid % nig) / gsz; return true;
    }
    DI unsigned arow(const Unit& u, int R) const { return (unsigned)((u.pm * BM + R) * K) * 2u; }
    DI const char* bbase(const Unit& u) const { return Bt + (size_t)u.pn * BM * K * 2; }
};
struct MoeUnit { int e, tile, sub, gt, nvalid; };
DI void moe_find(const LAS int* toff, const LAS int* lcnt, int rt, MoeUnit& u) {
    int lo = 0, hi = 64;
    while (lo < hi) { const int mid = (lo + hi + 1) >> 1; const int v = __builtin_amdgcn_readfirstlane(toff[mid]); if (v <= rt) lo = mid; else hi = mid - 1; }
    u.e = lo; u.tile = rt - __builtin_amdgcn_readfirstlane(toff[lo]); u.gt = rt;
    const int rem = __builtin_amdgcn_readfirstlane(lcnt[lo]) - u.tile * 256; u.nvalid = rem < 256 ? rem : 256;
}
struct SchedGU {
    typedef MoeUnit Unit;
    const LAS int* toff; const LAS int* lcnt; int total, G, c; const int* explist; const char* W;
    DI bool next(int i, Unit& u) const { const int L = i * G + c; if (L >= total) return false; u.sub = L & 1; moe_find(toff, lcnt, L >> 1, u); return true; }
    DI unsigned arow(const Unit& u, int R) const {
        int tok;
        if (u.e == NEXP) tok = u.tile * 256 + R;
        else { const int rr = R < u.nvalid ? R : 0; tok = explist[(size_t)u.e * CAP + u.tile * 256 + rr] >> 3; }
        return (unsigned)tok * (unsigned)(DM * 2);
    }
    DI const char* bbase(const Unit& u) const { return W + ((size_t)u.e * 512 + u.sub * 256) * (DM * 2); }
};
struct SchedDown {
    typedef MoeUnit Unit;
    const LAS int* toff; const LAS int* lcnt; int rt_lo, rt_hi, G, c; const char* W;
    DI bool next(int i, Unit& u) const { const int L = i * G + c; const int rt = rt_lo + (L >> 2); if (rt >= rt_hi) return false; u.sub = L & 3; moe_find(toff, lcnt, rt, u); return true; }
    DI unsigned arow(const Unit& u, int R) const { return (unsigned)(u.gt * 256 + R) * (unsigned)(DEXP * 2); }
    DI const char* bbase(const Unit& u) const { return W + ((size_t)u.e * 1024 + u.sub * 256) * (DEXP * 2); }
};

struct EpiRowScaleBf16 {
    static constexpr bool PERM = true;
    bf16_t* O; int ldc; const float* rs;
    DI void operator()(const f32x4 (&acc)[2][2][4][2], const SchedStatic::Unit& u, int wr, int wc, int fr, int fq) const {
        asm volatile("" : "+v"(fr));
        const int row0 = u.pm * BM + wr * 64 + fr, col0 = u.pn * BM + wc * 32 + 8 * fq;
#pragma unroll
        for (int ai = 0; ai < 2; ++ai)
#pragma unroll
            for (int m = 0; m < 4; ++m) { const int row = row0 + ai * HALF + m * 16; const float sc = rs ? rs[row] : 1.f; bf16_t* rowp = O + (size_t)row * ldc + col0;
#pragma unroll
                for (int bj = 0; bj < 2; ++bj) { const f32x4 v0 = acc[ai][bj][m][0] * sc, v1 = acc[ai][bj][m][1] * sc;
                    u32x4 w; w.x = pk2(v0[0], v0[1]); w.y = pk2(v0[2], v0[3]); w.z = pk2(v1[0], v1[1]); w.w = pk2(v1[2], v1[3]);
                    *(u32x4*)(rowp + bj * HALF) = w; } }
    }
};
struct EpiX1 {
    static constexpr bool PERM = false;
    const float* x; float* out; bf16_t* x1b;
    DI void operator()(const f32x4 (&acc)[2][2][4][2], const SchedStatic::Unit& u, int wr, int wc, int fr, int fq) const {
        asm volatile("" : "+v"(fr));
        const int row0 = u.pm * BM + wr * 64 + fr, col0 = u.pn * BM + wc * 32 + 4 * fq;
#pragma unroll
        for (int ai = 0; ai < 2; ++ai)
#pragma unroll
            for (int m = 0; m < 4; ++m) { const size_t rb = (size_t)(row0 + ai * HALF + m * 16) * DM + col0;
#pragma unroll
                for (int bj = 0; bj < 2; ++bj)
#pragma unroll
                    for (int n = 0; n < 2; ++n) { const size_t off = rb + bj * HALF + n * 16; const f32x4 v = *(const f32x4*)(x + off) + acc[ai][bj][m][n];
                        *(f32x4*)(out + off) = v; u32x2 w; w.x = pk2(v[0], v[1]); w.y = pk2(v[2], v[3]); *(u32x2*)(x1b + off) = w; }
                if (m & 1) asm volatile("" ::: "memory"); }
    }
};
struct EpiGU {
    static constexpr bool PERM = true;
    const int* explist; const float* rinv2; bf16_t* hid;
    DI void operator()(const f32x4 (&acc)[2][2][4][2], const MoeUnit& u, int wr, int wc, int fr, int fq) const {
        asm volatile("" : "+v"(fr));
#pragma unroll
        for (int ai = 0; ai < 2; ++ai)
#pragma unroll
            for (int m = 0; m < 4; ++m) { const int r = ai * HALF + wr * 64 + m * 16 + fr;
                int tok;
                if (u.e == NEXP) tok = u.tile * 256 + r;
                else { const int rr = r < u.nvalid ? r : 0; tok = explist[(size_t)u.e * CAP + u.tile * 256 + rr] >> 3; }
                const float rs = rinv2[tok];
                float hv[8];
#pragma unroll
                for (int n = 0; n < 2; ++n)
#pragma unroll
                    for (int q = 0; q < 4; ++q) { const float g = acc[ai][0][m][n][q] * rs, uu = acc[ai][1][m][n][q] * rs; hv[n * 4 + q] = g * sigmoidf_(g) * uu; }
                u32x4 w; w.x = pk2(hv[0], hv[1]); w.y = pk2(hv[2], hv[3]); w.z = pk2(hv[4], hv[5]); w.w = pk2(hv[6], hv[7]);
                *(u32x4*)(hid + ((size_t)u.gt * 256 + r) * DEXP + u.sub * 128 + wc * 32 + 8 * fq) = w;
                asm volatile("" ::: "memory"); }
    }
};
DI unsigned pk4_fp8(float a, float b, float c, float d) { int w = __builtin_amdgcn_cvt_pk_fp8_f32(a, b, 0, false); w = __builtin_amdgcn_cvt_pk_fp8_f32(c, d, w, true); return (unsigned)w; }
struct EpiDownR {
    static constexpr bool PERM = true;
    const int* explist; const float* gatew; unsigned char* y8;
    DI void operator()(const f32x4 (&acc)[2][2][4][2], const MoeUnit& u, int wr, int wc, int fr, int fq) const {
        asm volatile("" : "+v"(fr));
#pragma unroll
        for (int ai = 0; ai < 2; ++ai)
#pragma unroll
            for (int m = 0; m < 4; ++m) { const int r = ai * HALF + wr * 64 + m * 16 + fr;
                if (r < u.nvalid) { const int p = explist[(size_t)u.e * CAP + u.tile * 256 + r]; const float gw = gatew[p] * 8.f;
                    unsigned char* rowp = y8 + (size_t)p * DM + u.sub * 256 + wc * 32 + 8 * fq;
#pragma unroll
                    for (int bj = 0; bj < 2; ++bj) { const f32x4 v0 = acc[ai][bj][m][0] * gw, v1 = acc[ai][bj][m][1] * gw;
                        u32x2 w; w.x = pk4_fp8(v0[0], v0[1], v0[2], v0[3]); w.y = pk4_fp8(v1[0], v1[1], v1[2], v1[3]); *(u32x2*)(rowp + bj * HALF) = w; } }
                asm volatile("" ::: "memory"); }
    }
};
struct EpiDownS {
    static constexpr bool PERM = true;
    float* out;
    DI void operator()(const f32x4 (&acc)[2][2][4][2], const MoeUnit& u, int wr, int wc, int fr, int fq) const {
        asm volatile("" : "+v"(fr));
#pragma unroll
        for (int ai = 0; ai < 2; ++ai)
#pragma unroll
            for (int m = 0; m < 4; ++m) { const int r = ai * HALF + wr * 64 + m * 16 + fr; float* rowp = out + ((size_t)u.tile * 256 + r) * DM + u.sub * 256 + wc * 32 + 8 * fq;
#pragma unroll
                for (int bj = 0; bj < 2; ++bj)
#pragma unroll
                    for (int n = 0; n < 2; ++n) { float* p = rowp + bj * HALF + 4 * n; *(f32x4*)p = *(const f32x4*)p + acc[ai][bj][m][n]; }
                asm volatile("" ::: "memory"); }
    }
};
}

struct Ctx {
    unsigned char* lds_generic; LAS unsigned char* lds;
    int tid, lane, wid, G, vcu;
    float* out; unsigned char* ws;
};
struct Args { const float* in[28]; float* out; unsigned char* ws; int ph_lo, ph_hi; };

DI const float* in_ptr(int i) {
    const __attribute__((address_space(4))) char* ka = (const __attribute__((address_space(4))) char*)__builtin_amdgcn_kernarg_segment_ptr();
    unsigned off = (unsigned)i * 8u; asm volatile("" : "+s"(off));
    return *(const float* const __attribute__((address_space(4)))*)(ka + off);
}
DI void tr_item(const float* W, int ldn, int k0, int n0, bf16_t* WT, size_t drow0, int ldk, const float* scale, LAS float* scr, int lane) {
#pragma unroll 8
    for (int i = 0; i < 32; ++i) { const int kk = 2 * i + (lane >> 5); const float s = scale ? scale[kk] : 1.f; scr[kk * 33 + (lane & 31)] = W[(size_t)(k0 + kk) * ldn + n0 + (lane & 31)] * s; }
    LDS_WAIT(); asm volatile("" ::: "memory");
    const int c = lane & 7;
#pragma unroll
    for (int j = 0; j < 4; ++j) { const int n = (lane >> 3) + 8 * j; const LAS float* s = scr + (8 * c) * 33 + n;
        u32x4 o; o.x = pk2(s[0 * 33], s[1 * 33]); o.y = pk2(s[2 * 33], s[3 * 33]); o.z = pk2(s[4 * 33], s[5 * 33]); o.w = pk2(s[6 * 33], s[7 * 33]);
        *(u32x4*)(WT + (drow0 + n) * (size_t)ldk + k0 + 8 * c) = o; }
    LDS_WAIT(); asm volatile("" ::: "memory");
}
DI void p0_prologue(const Ctx& C) {
    LAS float* scr = (LAS float*)(C.lds + C.wid * 16384);
    const int gw = C.vcu * 8 + C.wid, NGW = C.G * 8, lane = C.lane;
    bf16_t* W1T = (bf16_t*)(C.ws + WS_W1T); bf16_t* W2T = (bf16_t*)(C.ws + WS_W2T); bf16_t* WMT = (bf16_t*)(C.ws + WS_WMT);
    bf16_t* WGU = (bf16_t*)(C.ws + WS_WGU); bf16_t* WD = (bf16_t*)(C.ws + WS_WD);
    constexpr int I_IN = 16 * 72, I_OUT = 16 * 32, I_MEM = 16 * 16, I_G = 16 * 8, I_D = 4 * 32;
    constexpr int NITEMS = I_IN + I_OUT + I_MEM + 65 * (2 * I_G + I_D);
    for (int it = gw; it < NITEMS; it += NGW) {
        int r = it;
        if (r < I_IN) { const int kb = r / 72, nb = r % 72; tr_item(in_ptr(4), DIN, 64 * kb, 32 * nb, W1T, (size_t)32 * nb, DM, in_ptr(2) + 64 * kb, scr, lane); continue; } r -= I_IN;
        if (r < I_OUT) { const int kb = r / 32, nb = r % 32, k0 = 64 * kb; const float* sc = k0 < 512 ? in_ptr(15) + k0 : (k0 < 768 ? in_ptr(16) + (k0 - 512) : in_ptr(17) + (k0 - 768));
            tr_item(in_ptr(18), DM, k0, 32 * nb, W2T, (size_t)32 * nb, DM, sc, scr, lane); continue; } r -= I_OUT;
        if (r < I_MEM) { const int kb = r / 16, nb = r % 16; tr_item(in_ptr(12), 512, 64 * kb, 32 * nb, WMT, (size_t)32 * nb, DM, in_ptr(3) + 64 * kb, scr, lane); continue; } r -= I_MEM;
        const int e = r / (2 * I_G + I_D); r -= e * (2 * I_G + I_D);
        if (r < 2 * I_G) { const int up = r >= I_G; if (up) r -= I_G; const int kb = r / 8, nb = r % 8, n0 = 32 * nb;
            const float* src = e < NEXP ? (up ? in_ptr(23) : in_ptr(22)) + (size_t)e * DM * DEXP : (up ? in_ptr(26) : in_ptr(25));
            const size_t drow0 = (size_t)e * 512 + (n0 >> 7) * 256 + (up ? 128 : 0) + (n0 & 127);
            tr_item(src, DEXP, 64 * kb, n0, WGU, drow0, DM, in_ptr(19) + 64 * kb, scr, lane); continue; }
        r -= 2 * I_G;
        { const int kb = r / 32, nb = r % 32; const float* src = e < NEXP ? in_ptr(24) + (size_t)e * DEXP * DM : in_ptr(27);
          tr_item(src, DM, 64 * kb, 32 * nb, WD, (size_t)e * 1024 + 32 * nb, DEXP, nullptr, scr, lane); }
    }
    { bf16_t* WRH = (bf16_t*)(C.ws + WS_WRHI); bf16_t* WRL = (bf16_t*)(C.ws + WS_WRLO);
      for (int idx = (C.vcu * 512 + C.tid); idx < DM * NEXP; idx += C.G * 512) { const int k = idx >> 6, n = idx & 63; const float v = in_ptr(20)[idx] * in_ptr(19)[k];
          const bf16_t h = f2bf(v); const bf16_t l = f2bf(v - bf2f(h)); WRH[n * DM + k] = h; WRL[n * DM + k] = l; } }
    { u32x4* RGW = (u32x4*)(C.ws + WS_RGW);
      for (int idx = C.vcu * 512 + C.tid; idx < 2 * 4 * 8 * 64; idx += C.G * 512) { const int ln = idx & 63, f = (idx >> 6) & 7, n = (idx >> 9) & 3, mat = idx >> 11; const int nb = f >> 1, kc = f & 1;
          const float* w = (mat ? in_ptr(9) : in_ptr(7)) + (size_t)n * 4096; const int c0 = 32 * kc + 8 * (ln >> 4), d = 16 * nb + (ln & 15);
          u32x4 o; o.x = pk2(w[(c0 + 0) * 64 + d], w[(c0 + 1) * 64 + d]); o.y = pk2(w[(c0 + 2) * 64 + d], w[(c0 + 3) * 64 + d]); o.z = pk2(w[(c0 + 4) * 64 + d], w[(c0 + 5) * 64 + d]); o.w = pk2(w[(c0 + 6) * 64 + d], w[(c0 + 7) * 64 + d]);
          RGW[idx] = o; } }
    { bf16_t* XB = (bf16_t*)(C.ws + WS_XB); float* R1 = (float*)(C.ws + WS_RINV1); bf16_t* MN = (bf16_t*)(C.ws + WS_MEMN);
      for (int m = gw; m < T_TOK + NMEM; m += NGW) {
          const bool ismem = m >= T_TOK; const float* src = ismem ? in_ptr(1) + (size_t)(m - T_TOK) * DM : in_ptr(0) + (size_t)m * DM;
          const f32x4* xr = (const f32x4*)src + lane; f32x4 v[4]; float s = 0.f;
#pragma unroll
          for (int j = 0; j < 4; ++j) { v[j] = xr[64 * j]; s += (v[j].x * v[j].x + v[j].y * v[j].y) + (v[j].z * v[j].z + v[j].w * v[j].w); }
          const float rinv = 1.0f / sqrtf(wave_sum(s) * (1.f / DM) + RMS_EPS);
          const float mul = ismem ? rinv : 1.f;
          bf16_t* dst = ismem ? MN + (size_t)(m - T_TOK) * DM : XB + (size_t)m * DM;
          u32x2* o8 = (u32x2*)dst + lane;
#pragma unroll
          for (int j = 0; j < 4; ++j) { u32x2 w; w.x = pk2(v[j].x * mul, v[j].y * mul); w.y = pk2(v[j].z * mul, v[j].w * mul); o8[64 * j] = w; }
          if (!ismem && lane == 0) R1[m] = rinv;
      } }
}

DI void stage_v(const bf16_t* gsrc, size_t pitch, LAS bf16_t* vs, int lane) {
    const int row = lane >> 1, c0 = (lane & 1) * 32;
    const u32x4* src = (const u32x4*)(gsrc + (size_t)row * pitch + c0);
    const u32x4 v0 = src[0], v1 = src[1], v2 = src[2], v3 = src[3];
    LAS u32x4* dst = (LAS u32x4*)(vs + row * 72 + c0);
    dst[0] = v0; dst[1] = v1; dst[2] = v2; dst[3] = v3;
}
DI void sb_unit(const bf16_t* proj, bf16_t* obuf, LAS bf16_t* vs, int b, int hd, int qb, int wid, int lane) {
    const int r = lane & 31, h = lane >> 5;
    const int t0 = qb * 256 + wid * 32;
    const size_t rowb = (size_t)b * SEQ;
    bf16x8 qf[4];
    { const bf16_t* qp = proj + (rowb + t0 + r) * DIN + COL_Q + hd * 64 + 8 * h;
#pragma unroll
      for (int c = 0; c < 4; ++c) qf[c] = *(const bf16x8*)(qp + 16 * c); }
    f32x16 o0, o1;
#pragma unroll
    for (int i = 0; i < 16; ++i) { o0[i] = 0.f; o1[i] = 0.f; }
    float R = 0.f;
    const int tq = t0 + r;
    for (int kb = t0 >> 5; kb >= 0; --kb) {
        const int s0 = kb * 32;
        bf16x8 kf[4];
        { const bf16_t* kp = proj + (rowb + s0 + r) * DIN + COL_K + hd * 64 + 8 * h;
#pragma unroll
          for (int c = 0; c < 4; ++c) kf[c] = *(const bf16x8*)(kp + 16 * c); }
        stage_v(proj + (rowb + s0) * DIN + COL_V + hd * 64, DIN, vs, lane);
        f32x16 p;
#pragma unroll
        for (int i = 0; i < 16; ++i) p[i] = 0.f;
#pragma unroll
        for (int c = 0; c < 4; ++c) p = MFMA32(kf[c], qf[c], p);
        float z[16], cs[16], Tg[4], Pg[4], Eg[4];
#pragma unroll
        for (int g = 0; g < 4; ++g) {
            float run = 0.f;
#pragma unroll
            for (int j = 3; j >= 0; --j) { const int i = 4 * g + j; const int kv = s0 + crow(i, h); const bool valid = kv < tq;
                const float zz = p[i] * 0.125f; z[i] = zz;
                const float sp = fmaxf(zz, 0.f) + __logf(1.f + __expf(-fabsf(zz)));
                run += valid ? -sp : 0.f; cs[i] = run; }
            Tg[g] = run;
        }
#pragma unroll
        for (int g = 0; g < 4; ++g) Pg[g] = __shfl_xor(Tg[g], 32);
        float after = 0.f;
#pragma unroll
        for (int g = 3; g >= 0; --g) { Eg[g] = after + (h == 0 ? Pg[g] : 0.f); after += Tg[g] + Pg[g]; }
        float w[16];
#pragma unroll
        for (int i = 0; i < 16; ++i) { const int kv = s0 + crow(i, h); const bool valid = kv < tq; const float lw = z[i] + cs[i] + Eg[i >> 2] + R; w[i] = valid ? __expf(lw) : 0.f; }
        R += after;
#pragma unroll
        for (int s = 0; s < 2; ++s) {
            u32x4 xw; xw.x = pk2(w[8 * s + 0], w[8 * s + 1]); xw.y = pk2(w[8 * s + 2], w[8 * s + 3]); xw.z = pk2(w[8 * s + 4], w[8 * s + 5]); xw.w = pk2(w[8 * s + 6], w[8 * s + 7]);
            const bf16x8 xs = __builtin_bit_cast(bf16x8, xw);
#pragma unroll
            for (int dh = 0; dh < 2; ++dh) {
                bf16x8 pb;
#pragma unroll
                for (int j = 0; j < 8; ++j) pb[j] = (short)vs[(16 * s + 8 * (j >> 2) + 4 * h + (j & 3)) * 72 + 32 * dh + r];
                if (dh == 0) o0 = MFMA32(xs, pb, o0); else o1 = MFMA32(xs, pb, o1);
            }
        }
        if (__all(R < -105.f)) break;
    }
#pragma unroll
    for (int i = 0; i < 16; ++i) { bf16_t* op = obuf + (rowb + t0 + crow(i, h)) * DM + hd * 64 + r; op[0] = f2bf(o0[i]); op[32] = f2bf(o1[i]); }
}
DI void ca_unit(const bf16_t* proj, const bf16_t* kvm, const float* qg, const float* kg, bf16_t* obuf, LAS bf16_t* vs, int b, int hd, int qb, int wid, int lane) {
    const int r = lane & 31, h = lane >> 5;
    const int t0 = qb * 256 + wid * 32;
    const size_t rowb = (size_t)b * SEQ;
    bf16x8 qf[4];
    { const bf16_t* qp = proj + (rowb + t0 + r) * DIN + COL_QCA + hd * 64 + 8 * h;
      float qv[4][8]; float ss = 0.f;
#pragma unroll
      for (int c = 0; c < 4; ++c) { const u32x4 raw = *(const u32x4*)(qp + 16 * c);
#pragma unroll
          for (int q = 0; q < 4; ++q) { qv[c][2 * q] = bflo(raw[q]); qv[c][2 * q + 1] = bfhi(raw[q]); ss += qv[c][2 * q] * qv[c][2 * q] + qv[c][2 * q + 1] * qv[c][2 * q + 1]; } }
      ss += __shfl_xor(ss, 32);
      const float rq = (1.0f / sqrtf(ss * (1.f / 64.f) + RMS_EPS)) * 0.125f;
#pragma unroll
      for (int c = 0; c < 4; ++c) { const float* g = qg + 16 * c + 8 * h; u32x4 w;
#pragma unroll
          for (int q = 0; q < 4; ++q) w[q] = pk2(qv[c][2 * q] * rq * g[2 * q], qv[c][2 * q + 1] * rq * g[2 * q + 1]);
          qf[c] = __builtin_bit_cast(bf16x8, w); } }
#define CA_QK(kb, accv) do { const bf16_t* kp = kvm + ((size_t)b * MEMLEN + (kb) * 32 + r) * 512 + hd * 64 + 8 * h; \
        u32x4 raw[4]; float ss_ = 0.f; \
        _Pragma("unroll") for (int c = 0; c < 4; ++c) { raw[c] = *(const u32x4*)(kp + 16 * c); \
            _Pragma("unroll") for (int q = 0; q < 4; ++q) { const float a_ = bflo(raw[c][q]), b_ = bfhi(raw[c][q]); ss_ += a_ * a_ + b_ * b_; } } \
        ss_ += __shfl_xor(ss_, 32); \
        const float rk = 1.0f / sqrtf(ss_ * (1.f / 64.f) + RMS_EPS); \
        _Pragma("unroll") for (int i = 0; i < 16; ++i) accv[i] = 0.f; \
        _Pragma("unroll") for (int c = 0; c < 4; ++c) { const float* g = kg + 16 * c + 8 * h; u32x4 w_; \
            _Pragma("unroll") for (int q = 0; q < 4; ++q) w_[q] = pk2(bflo(raw[c][q]) * rk * g[2 * q], bfhi(raw[c][q]) * rk * g[2 * q + 1]); \
            accv = MFMA32(__builtin_bit_cast(bf16x8, w_), qf[c], accv); } } while (0)
    float mx = -3.0e38f;
    for (int kb = 0; kb < 8; ++kb) {
        f32x16 p; CA_QK(kb, p);
#pragma unroll
        for (int i = 0; i < 16; ++i) mx = fmaxf(mx, p[i]);
    }
    mx = fmaxf(mx, __shfl_xor(mx, 32));
    float l = 0.f;
    f32x16 o0, o1;
#pragma unroll
    for (int i = 0; i < 16; ++i) { o0[i] = 0.f; o1[i] = 0.f; }
    for (int kb = 0; kb < 8; ++kb) {
        stage_v(kvm + ((size_t)b * MEMLEN + kb * 32) * 512 + 256 + hd * 64, 512, vs, lane);
        f32x16 p; CA_QK(kb, p);
#pragma unroll
        for (int i = 0; i < 16; ++i) { const float e = __expf(p[i] - mx); p[i] = e; l += e; }
#pragma unroll
        for (int s = 0; s < 2; ++s) {
            u32x4 xw;
#pragma unroll
            for (int q = 0; q < 4; ++q) xw[q] = pk2(p[8 * s + 2 * q], p[8 * s + 2 * q + 1]);
            const bf16x8 xs = __builtin_bit_cast(bf16x8, xw);
#pragma unroll
            for (int dh = 0; dh < 2; ++dh) {
                bf16x8 pb;
#pragma unroll
                for (int j = 0; j < 8; ++j) pb[j] = (short)vs[(16 * s + 8 * (j >> 2) + 4 * h + (j & 3)) * 72 + 32 * dh + r];
                if (dh == 0) o0 = MFMA32(xs, pb, o0); else o1 = MFMA32(xs, pb, o1);
            }
        }
    }
#undef CA_QK
    l += __shfl_xor(l, 32);
    const float inv = 1.f / l;
#pragma unroll
    for (int i = 0; i < 16; ++i) { const float iv = __shfl(inv, crow(i, h)); bf16_t* op = obuf + (rowb + t0 + crow(i, h)) * DM + 768 + hd * 64 + r; op[0] = f2bf(o0[i] * iv); op[32] = f2bf(o1[i] * iv); }
}
DI float neg_expm1(float x) {
    if (x > -0.25f) { return -x * (1.f + x * (0.5f + x * (0.16666667f + x * (0.041666668f + x * (0.0083333338f + x * 0.0013888889f))))); }
    return 1.f - __expf(x);
}
DI float gelu_tanh(float x) { const float y = 0.7978845608f * (x + 0.044715f * x * x * x); const float t = 1.f - 2.f / (__expf(2.f * y) + 1.f); return 0.5f * x * (1.f + t); }
template <bool PASS2>
DI void rg_wave(const Ctx& C, int b, int chunk, LAS unsigned char* wscr, LAS float* ssq) {
    const int lane = C.lane, n = C.wid & 3, half = C.wid >> 2, ch = 64 * n + lane;
    const bf16_t* proj = (const bf16_t*)(C.ws + WS_PROJ);
    float* seg = (float*)(C.ws + WS_SEG);
    bf16_t* obuf = (bf16_t*)(C.ws + WS_O);
    const int tl0 = half * 128, t_start = chunk * 256 + tl0, sidx = chunk * 2 + half;
    const size_t rowb = (size_t)b * SEQ;
    const float cw0 = in_ptr(5)[0 * 256 + ch], cw1 = in_ptr(5)[1 * 256 + ch], cw2 = in_ptr(5)[2 * 256 + ch], cw3 = in_ptr(5)[3 * 256 + ch], cb = in_ptr(6)[ch];
    const float brg = in_ptr(8)[ch], big = in_ptr(10)[ch];
    const float lam = in_ptr(11)[ch];
    const float c8 = -8.f * (fmaxf(-lam, 0.f) + __logf(1.f + __expf(-fabsf(lam))));
    bf16x8 wrf[4][2], wif[4][2];
    { const bf16x8* fr_ = (const bf16x8*)(C.ws + WS_RGW) + (size_t)(n * 8) * 64 + lane; const bf16x8* fi_ = fr_ + 4 * 8 * 64;
#pragma unroll
      for (int nb = 0; nb < 4; ++nb)
#pragma unroll
          for (int kc = 0; kc < 2; ++kc) { wrf[nb][kc] = fr_[(nb * 2 + kc) * 64]; wif[nb][kc] = fi_[(nb * 2 + kc) * 64]; } }
    float hst = 0.f, aprod = 1.f;
    if (PASS2) {
        const float* sp = seg + ((size_t)b * 32 * 256 + ch) * 2;
#pragma unroll 4
        for (int s = 0; s < sidx; ++s) { const f32x2 v = *(const f32x2*)(sp + (size_t)s * 512); hst = v.x * hst + v.y; }
    }
    float x3 = 0.f, x2 = 0.f, x1 = 0.f;
    if (t_start > 0) { const bf16_t* xp = proj + (rowb + t_start - 3) * DIN + COL_XRG + ch; x3 = bf2f(xp[0]); x2 = bf2f(xp[DIN]); x1 = bf2f(xp[2 * DIN]); }
    LAS bf16_t* At = (LAS bf16_t*)wscr;
    LAS float* Pr = (LAS float*)(wscr + 2304);
    LAS float* Pi = (LAS float*)(wscr + 2304 + 4096);
    LAS float* Xc = (LAS float*)(wscr + 2304 + 8192);
    for (int sub = 0; sub < 8; ++sub) {
        const int tb = t_start + sub * 16;
#pragma unroll 4
        for (int tt = 0; tt < 16; ++tt) { const float x0 = bf2f(proj[(rowb + tb + tt) * DIN + COL_XRG + ch]);
            const float v = cb + cw0 * x3 + cw1 * x2 + cw2 * x1 + cw3 * x0; Xc[tt * 64 + lane] = v; x3 = x2; x2 = x1; x1 = x0; At[tt * 72 + lane] = f2bf(v); }
        LDS_WAIT(); asm volatile("" ::: "memory");
        bf16x8 af[2];
#pragma unroll
        for (int kc = 0; kc < 2; ++kc) af[kc] = *(const LAS bf16x8*)(At + (lane & 15) * 72 + 32 * kc + 8 * (lane >> 4));
#pragma unroll
        for (int nb = 0; nb < 4; ++nb) { f32x4 ar = {0.f, 0.f, 0.f, 0.f}, ai = {0.f, 0.f, 0.f, 0.f};
#pragma unroll
            for (int kc = 0; kc < 2; ++kc) { ar = MFMA16(af[kc], wrf[nb][kc], ar); ai = MFMA16(af[kc], wif[nb][kc], ai); }
#pragma unroll
            for (int q = 0; q < 4; ++q) { const int t = 4 * (lane >> 4) + q, d = 16 * nb + (lane & 15); Pr[t * 64 + d] = ar[q]; Pi[t * 64 + d] = ai[q]; } }
        LDS_WAIT(); asm volatile("" ::: "memory");
#pragma unroll 2
        for (int tt = 0; tt < 16; ++tt) {
            const float rr = sigmoidf_(Pr[tt * 64 + lane] + brg), ii = sigmoidf_(Pi[tt * 64 + lane] + big);
            const float la = c8 * rr, a = __expf(la), mult = sqrtf(neg_expm1(2.f * la));
            hst = a * hst + mult * ii * Xc[tt * 64 + lane]; aprod *= a;
            if (PASS2) { const size_t row = rowb + tb + tt; const float gate = bf2f(proj[row * DIN + COL_GRG + ch]); const float o = gelu_tanh(gate) * hst;
                obuf[row * DM + 512 + ch] = f2bf(o); const float s2 = wave_sum(o * o); if (lane == 0) ssq[n * 256 + tl0 + sub * 16 + tt] = s2; }
        }
        LDS_WAIT(); asm volatile("" ::: "memory");
    }
    if (!PASS2) { *(f32x2*)(seg + (((size_t)b * 32 + sidx) * 256 + ch) * 2) = (f32x2){aprod, hst}; }
}
DI void p2_mixers(const Ctx& C) {
    const bf16_t* proj = (const bf16_t*)(C.ws + WS_PROJ); const bf16_t* kvm = (const bf16_t*)(C.ws + WS_KVM); bf16_t* obuf = (bf16_t*)(C.ws + WS_O);
    constexpr int N_RG = 256, N_CA = NBATCH * 4 * 16, N_SB = NBATCH * 8 * 16;
    for (int L = C.vcu; L < N_RG + N_CA + N_SB; L += C.G) {
        if (L < N_RG) { rg_wave<false>(C, L >> 4, L & 15, C.lds + C.wid * 15360, nullptr); }
        else if (L < N_RG + N_CA) { const int u = L - N_RG; const int qb = u & 15, hd = (u >> 4) & 3, b = u >> 6; ca_unit(proj, kvm, in_ptr(13), in_ptr(14), obuf, (LAS bf16_t*)(C.lds + C.wid * 15360), b, hd, qb, C.wid, C.lane); }
        else { const int u = L - N_RG - N_CA; const int qb = u & 15, hd = (u >> 4) & 7, b = u >> 7; sb_unit(proj, obuf, (LAS bf16_t*)(C.lds + C.wid * 15360), b, hd, qb, C.wid, C.lane); }
    }
}
DI void p3_norm(const Ctx& C) {
    bf16_t* obuf = (bf16_t*)(C.ws + WS_O);
    LAS float* ssq = (LAS float*)(C.lds + 122880);
    for (int L = C.vcu; L < 256; L += C.G) {
        const int b = L >> 4, chunk = L & 15;
        rg_wave<true>(C, b, chunk, C.lds + C.wid * 15360, ssq);
        VM_WAIT(); __syncthreads();
        for (int rr = 0; rr < 32; ++rr) {
            const int tl = C.wid * 32 + rr; const size_t row = (size_t)b * SEQ + chunk * 256 + tl; bf16_t* rp = obuf + row * DM; const int lane = C.lane;
            const u32x4 sb = *(const u32x4*)(rp + 8 * lane); const u32x2 rg = *(const u32x2*)(rp + 512 + 4 * lane); const u32x2 ca = *(const u32x2*)(rp + 768 + 4 * lane);
            float vs[8], vr[4], vc[4]; float s_sb = 0.f, s_ca = 0.f;
#pragma unroll
            for (int q = 0; q < 4; ++q) { vs[2 * q] = bflo(sb[q]); vs[2 * q + 1] = bfhi(sb[q]); s_sb += vs[2 * q] * vs[2 * q] + vs[2 * q + 1] * vs[2 * q + 1]; }
#pragma unroll
            for (int q = 0; q < 2; ++q) { vr[2 * q] = bflo(rg[q]); vr[2 * q + 1] = bfhi(rg[q]); vc[2 * q] = bflo(ca[q]); vc[2 * q + 1] = bfhi(ca[q]); s_ca += vc[2 * q] * vc[2 * q] + vc[2 * q + 1] * vc[2 * q + 1]; }
            s_sb = wave_sum(s_sb); s_ca = wave_sum(s_ca);
            const float s_rg = (ssq[tl] + ssq[256 + tl]) + (ssq[512 + tl] + ssq[768 + tl]);
            const float i_sb = 1.0f / sqrtf(s_sb * (1.f / 512.f) + RMS_EPS), i_rg = 1.0f / sqrtf(s_rg * (1.f / 256.f) + RMS_EPS), i_ca = 1.0f / sqrtf(s_ca * (1.f / 256.f) + RMS_EPS);
            u32x4 w; w.x = pk2(vs[0] * i_sb, vs[1] * i_sb); w.y = pk2(vs[2] * i_sb, vs[3] * i_sb); w.z = pk2(vs[4] * i_sb, vs[5] * i_sb); w.w = pk2(vs[6] * i_sb, vs[7] * i_sb);
            *(u32x4*)(rp + 8 * lane) = w;
            u32x2 w2; w2.x = pk2(vr[0] * i_rg, vr[1] * i_rg); w2.y = pk2(vr[2] * i_rg, vr[3] * i_rg); *(u32x2*)(rp + 512 + 4 * lane) = w2;
            u32x2 w3; w3.x = pk2(vc[0] * i_ca, vc[1] * i_ca); w3.y = pk2(vc[2] * i_ca, vc[3] * i_ca); *(u32x2*)(rp + 768 + 4 * lane) = w3;
        }
        __syncthreads();
    }
}
DI void p5_router(const Ctx& C) {
    const float* x1 = C.out; float* rinv2 = (float*)(C.ws + WS_RINV2); float* gatew = (float*)(C.ws + WS_GATEW); int* explist = (int*)(C.ws + WS_EXPL);
    const bf16_t* WRH = (const bf16_t*)(C.ws + WS_WRHI); const bf16_t* WRL = (const bf16_t*)(C.ws + WS_WRLO);
    unsigned* cnt = (unsigned*)(C.ws + WS_CTL) + CW_CNT;
    LAS float* lg = (LAS float*)C.lds;
    LAS int* sel_e = (LAS int*)(C.lds + 66560);
    LAS float* sel_w = (LAS float*)(C.lds + 66560 + 8192);
    LAS int* sel_r = (LAS int*)(C.lds + 66560 + 16384);
    LAS int* lcount = (LAS int*)(C.lds + 66560 + 24576);
    LAS int* lbase = (LAS int*)(C.lds + 66560 + 24576 + 256);
    LAS float* lbias = (LAS float*)(C.lds + 66560 + 24576 + 512);
    const int lane = C.lane, wid = C.wid, tid = C.tid;
    for (int L = C.vcu; L < 256; L += C.G) {
        if (tid < 64) { lcount[tid] = 0; lbias[tid] = in_ptr(21)[tid]; }
        const int tbase = L * 256 + wid * 32;
        f32x4 acc[2][4];
#pragma unroll
        for (int m = 0; m < 2; ++m)
#pragma unroll
            for (int n = 0; n < 4; ++n) acc[m][n] = (f32x4){0.f, 0.f, 0.f, 0.f};
        float ss[2] = {0.f, 0.f};
        const int kq = lane >> 4, l15 = lane & 15;
        for (int k0 = 0; k0 < DM; k0 += 32) {
            bf16x8 ahi[2], alo[2];
#pragma unroll
            for (int m = 0; m < 2; ++m) { const float* p = x1 + (size_t)(tbase + 16 * m + l15) * DM + k0 + 8 * kq; const f32x4 v0 = *(const f32x4*)p, v1 = *(const f32x4*)(p + 4);
                ss[m] += (v0[0] * v0[0] + v0[1] * v0[1]) + (v0[2] * v0[2] + v0[3] * v0[3]) + (v1[0] * v1[0] + v1[1] * v1[1]) + (v1[2] * v1[2] + v1[3] * v1[3]);
                u32x4 hh, ll;
                hh.x = pk2(v0[0], v0[1]); hh.y = pk2(v0[2], v0[3]); hh.z = pk2(v1[0], v1[1]); hh.w = pk2(v1[2], v1[3]);
                ll.x = pk2(v0[0] - bflo(hh.x), v0[1] - bfhi(hh.x)); ll.y = pk2(v0[2] - bflo(hh.y), v0[3] - bfhi(hh.y));
                ll.z = pk2(v1[0] - bflo(hh.z), v1[1] - bfhi(hh.z)); ll.w = pk2(v1[2] - bflo(hh.w), v1[3] - bfhi(hh.w));
                ahi[m] = __builtin_bit_cast(bf16x8, hh); alo[m] = __builtin_bit_cast(bf16x8, ll); }
#pragma unroll
            for (int n = 0; n < 4; ++n) { const size_t wo = (size_t)(16 * n + l15) * DM + k0 + 8 * kq; const bf16x8 bh = *(const bf16x8*)(WRH + wo), bl = *(const bf16x8*)(WRL + wo);
#pragma unroll
                for (int m = 0; m < 2; ++m) { acc[m][n] = MFMA16(bh, ahi[m], acc[m][n]); acc[m][n] = MFMA16(bh, alo[m], acc[m][n]); acc[m][n] = MFMA16(bl, ahi[m], acc[m][n]); } }
        }
#pragma unroll
        for (int m = 0; m < 2; ++m) { float s = ss[m]; s += __shfl_xor(s, 16); s += __shfl_xor(s, 32); const float rinv = 1.0f / sqrtf(s * (1.f / DM) + RMS_EPS);
            const int tl = wid * 32 + 16 * m + l15; if (kq == 0) rinv2[L * 256 + tl] = rinv;
#pragma unroll
            for (int n = 0; n < 4; ++n)
#pragma unroll
                for (int q = 0; q < 4; ++q) lg[tl * 65 + 16 * n + 4 * kq + q] = acc[m][n][q] * rinv; }
        __syncthreads();
        if (tid < 256) {
            LAS float* row = lg + tid * 65;
            for (int e = 0; e < 64; ++e) { const float s = sigmoidf_(row[e]); row[e] = s + lbias[e]; }
            float gs[8];
#pragma unroll
            for (int g = 0; g < 8; ++g) { float m1 = -3.0e38f, m2 = -3.0e38f;
                for (int j = 0; j < 8; ++j) { const float v = row[8 * g + j]; if (v > m1) { m2 = m1; m1 = v; } else if (v > m2) m2 = v; }
                gs[g] = m1 + m2; }
            unsigned gmask = 0u;
#pragma unroll
            for (int it = 0; it < 4; ++it) { float best = -3.0e38f; int bi = 0;
#pragma unroll
                for (int g = 0; g < 8; ++g) { const bool free_ = !((gmask >> g) & 1u); if (free_ && gs[g] > best) { best = gs[g]; bi = g; } }
                gmask |= 1u << bi; }
            unsigned long long chosen = 0ull; float wsum = 0.f;
            for (int k = 0; k < 8; ++k) { float best = -3.0e38f; int be = 0;
                for (int g = 0; g < 8; ++g) { if (!((gmask >> g) & 1u)) continue;
                    for (int j = 0; j < 8; ++j) { const int e = 8 * g + j; if ((chosen >> e) & 1ull) continue; const float v = row[e]; if (v > best) { best = v; be = e; } } }
                chosen |= 1ull << be; const float w = best - lbias[be]; wsum += w; sel_e[tid * 8 + k] = be; sel_w[tid * 8 + k] = w;
                sel_r[tid * 8 + k] = __hip_atomic_fetch_add(lcount + be, 1, __ATOMIC_RELAXED, __HIP_MEMORY_SCOPE_WORKGROUP); }
            const float sc = 2.5f / (wsum + 1e-20f);
            for (int k = 0; k < 8; ++k) sel_w[tid * 8 + k] *= sc;
        }
        __syncthreads();
        if (tid < 64) lbase[tid] = (int)__hip_atomic_fetch_add(cnt + tid, (unsigned)lcount[tid], __ATOMIC_RELAXED, __HIP_MEMORY_SCOPE_AGENT);
        __syncthreads();
        if (tid < 256) { const int tok = L * 256 + tid;
            for (int k = 0; k < 8; ++k) { const int e = sel_e[tid * 8 + k]; const int pos = lbase[e] + sel_r[tid * 8 + k]; explist[(size_t)e * CAP + pos] = tok * 8 + k; gatew[tok * 8 + k] = sel_w[tid * 8 + k]; } }
        __syncthreads();
    }
}
DI void moe_prep(const Ctx& C, LAS int* toff, LAS int* lcnt) {
    unsigned* cnt = (unsigned*)(C.ws + WS_CTL) + CW_CNT;
    if (C.tid < 65) lcnt[C.tid] = C.tid < 64 ? (int)__hip_atomic_load(cnt + C.tid, RLX_AGENT) : T_TOK;
    __syncthreads();
    if (C.tid == 0) { int s = 0; for (int e = 0; e < 65; ++e) { toff[e] = s; s += (lcnt[e] + 255) >> 8; } toff[65] = s; }
    __syncthreads();
}
DI void p8_combine(const Ctx& C) {
    const unsigned char* y8 = C.ws + WS_Y8; float* out = C.out;
    const int gw = C.vcu * 8 + C.wid, NGW = C.G * 8, lane = C.lane;
    for (int tok = gw; tok < T_TOK; tok += NGW) {
        float a[16];
        float* op = out + (size_t)tok * DM + 16 * lane;
#pragma unroll
        for (int q = 0; q < 4; ++q) { const f32x4 v = *(const f32x4*)(op + 4 * q); a[4 * q] = v[0]; a[4 * q + 1] = v[1]; a[4 * q + 2] = v[2]; a[4 * q + 3] = v[3]; }
        float s[16];
#pragma unroll
        for (int i = 0; i < 16; ++i) s[i] = 0.f;
#pragma unroll
        for (int k = 0; k < 8; ++k) { const u32x4 w = *(const u32x4*)(y8 + ((size_t)tok * 8 + k) * DM + 16 * lane);
#pragma unroll
            for (int q = 0; q < 4; ++q) { const f32x2 lo = __builtin_amdgcn_cvt_pk_f32_fp8((int)w[q], false), hi = __builtin_amdgcn_cvt_pk_f32_fp8((int)w[q], true);
                s[4 * q] += lo[0]; s[4 * q + 1] += lo[1]; s[4 * q + 2] += hi[0]; s[4 * q + 3] += hi[1]; } }
#pragma unroll
        for (int q = 0; q < 4; ++q) { f32x4 v; v[0] = a[4 * q] + 0.125f * s[4 * q]; v[1] = a[4 * q + 1] + 0.125f * s[4 * q + 1]; v[2] = a[4 * q + 2] + 0.125f * s[4 * q + 2]; v[3] = a[4 * q + 3] + 0.125f * s[4 * q + 3]; *(f32x4*)(op + 4 * q) = v; }
    }
}

__global__ void __launch_bounds__(512, 2) mk_fwd(Args args) {
    extern __shared__ __attribute__((aligned(16))) unsigned char lds_raw[];
    Ctx C;
    C.lds_generic = lds_raw; C.lds = (LAS unsigned char*)lds_raw;
    C.tid = threadIdx.x; C.lane = C.tid & 63; C.wid = __builtin_amdgcn_readfirstlane(C.tid >> 6);
    C.G = gridDim.x; { const int bx = blockIdx.x; C.vcu = (C.G % 8 == 0) ? (bx % 8) * (C.G / 8) + bx / 8 : bx; }
    C.out = args.out; C.ws = args.ws;
    for (int u = C.tid; u < (LDS_BYTES - LDSCTL_OFF) / 4; u += 512) ((LAS unsigned*)(C.lds + LDSCTL_OFF))[u] = 0u;
    __syncthreads();
    const int lo = args.ph_lo, hi = args.ph_hi;
    unsigned* ctl = (unsigned*)(C.ws + WS_CTL);
    XcdBarrier bar; bar.bar = ctl + CW_BAR; bar.x = 0; bar.st = nullptr;
    if (hi - lo > 1) bar = xcd_barrier_post(ctl + CW_BAR, (volatile LAS unsigned*)(C.lds + MISC_OFF) + 8);
#ifndef MK_PHASE_MASK
#define MK_PHASE_MASK 0x1ff
#endif
#define IN(k) (((MK_PHASE_MASK >> (k)) & 1) && lo <= (k) && (k) < hi)
#define SEAM(k) do { if (IN(k) && IN((k) + 1)) xcd_barrier(bar); } while (0)
    LAS int* toff = (LAS int*)(C.lds + TOFF_OFF); LAS int* lcnt = (LAS int*)(C.lds + LCNT_OFF); LAS unsigned* tab = (LAS unsigned*)(C.lds + TAB_OFF);

    if (IN(0)) { p0_prologue(C); SEAM(0); }
    if (IN(1)) {
        { pg8::SchedStatic S; S.init(T_TOK, DIN, DM, C.G, (int)blockIdx.x, C.ws + WS_W1T);
          pg8::EpiRowScaleBf16 E{(bf16_t*)(C.ws + WS_PROJ), DIN, (const float*)(C.ws + WS_RINV1)};
          pg8::gemm_phase(C.lds, tab, (const char*)(C.ws + WS_XB), DM, S, E); }
        { pg8::SchedStatic S; S.init(NMEM, 512, DM, C.G, (int)blockIdx.x, C.ws + WS_WMT);
          pg8::EpiRowScaleBf16 E{(bf16_t*)(C.ws + WS_KVM), 512, nullptr};
          pg8::gemm_phase(C.lds, tab, (const char*)(C.ws + WS_MEMN), DM, S, E); }
        SEAM(1);
    }
    if (IN(2)) { p2_mixers(C); SEAM(2); }
    if (IN(3)) { p3_norm(C); SEAM(3); }
    if (IN(4)) {
        pg8::SchedStatic S; S.init(T_TOK, DM, DM, C.G, (int)blockIdx.x, C.ws + WS_W2T);
        pg8::EpiX1 E{in_ptr(0), C.out, (bf16_t*)(C.ws + WS_X1B)};
        pg8::gemm_phase(C.lds, tab, (const char*)(C.ws + WS_O), DM, S, E);
        SEAM(4);
    }
    if (IN(5)) { p5_router(C); SEAM(5); }
    if (IN(6)) {
        moe_prep(C, toff, lcnt);
        pg8::SchedGU S{toff, lcnt, 2 * __builtin_amdgcn_readfirstlane(toff[65]), C.G, C.vcu, (const int*)(C.ws + WS_EXPL), (const char*)(C.ws + WS_WGU)};
        pg8::EpiGU E{(const int*)(C.ws + WS_EXPL), (const float*)(C.ws + WS_RINV2), (bf16_t*)(C.ws + WS_HID)};
        pg8::gemm_phase(C.lds, tab, (const char*)(C.ws + WS_X1B), DM, S, E);
        SEAM(6);
    }
    if (IN(7)) {
        moe_prep(C, toff, lcnt);
        { pg8::SchedDown S{toff, lcnt, 0, __builtin_amdgcn_readfirstlane(toff[64]), C.G, C.vcu, (const char*)(C.ws + WS_WD)};
          pg8::EpiDownR E{(const int*)(C.ws + WS_EXPL), (const float*)(C.ws + WS_GATEW), C.ws + WS_Y8};
          pg8::gemm_phase(C.lds, tab, (const char*)(C.ws + WS_HID), DEXP, S, E); }
        { pg8::SchedDown S{toff, lcnt, __builtin_amdgcn_readfirstlane(toff[64]), __builtin_amdgcn_readfirstlane(toff[65]), C.G, C.vcu, (const char*)(C.ws + WS_WD)};
          pg8::EpiDownS E{C.out};
          pg8::gemm_phase(C.lds, tab, (const char*)(C.ws + WS_HID), DEXP, S, E); }
        SEAM(7);
    }
    if (IN(8)) { p8_combine(C); }
#undef IN
#undef SEAM
}

extern "C" void kernel_launch(void* const* d_in, const int* in_sizes, int n_in, void* d_out, int out_size, void* d_ws, size_t ws_size, hipStream_t stream) {
    static int grid = 0;
    if (grid == 0) {
        if (n_in != 28 || out_size != T_TOK * DM || ws_size < WS_END) { fprintf(stderr, "kernel_launch: unexpected shapes (n_in %d out %d ws %zu)\n", n_in, out_size, ws_size); grid = -1; return; }
        int dev = 0, cus = 0, per_cu = 0;
        if (hipGetDevice(&dev) != hipSuccess || hipDeviceGetAttribute(&cus, hipDeviceAttributeMultiprocessorCount, dev) != hipSuccess) { grid = -1; return; }
        if (hipFuncSetAttribute((const void*)mk_fwd, hipFuncAttributeMaxDynamicSharedMemorySize, LDS_BYTES) != hipSuccess) { fprintf(stderr, "kernel_launch: hipFuncSetAttribute failed\n"); grid = -1; return; }
        if (hipOccupancyMaxActiveBlocksPerMultiprocessor(&per_cu, (const void*)mk_fwd, 512, LDS_BYTES) != hipSuccess || per_cu < 1) fprintf(stderr, "kernel_launch: occupancy query says %d\n", per_cu);
        (void)hipGetLastError();
        grid = cus;
    }
    if (grid < 0) return;
    (void)hipMemsetAsync((char*)d_ws + WS_CTL, 0, CTL_ZERO_BYTES, stream);
    Args a{};
    for (int i = 0; i < 28; ++i) a.in[i] = (const float*)d_in[i];
    a.out = (float*)d_out; a.ws = (unsigned char*)d_ws;
    if (MK_N_LAUNCHES == 1) { a.ph_lo = 0; a.ph_hi = NPHASE; hipLaunchKernelGGL(mk_fwd, dim3(grid), dim3(512), LDS_BYTES, stream, a); }
    else { for (int p = 0; p < NPHASE; ++p) { a.ph_lo = p; a.ph_hi = p + 1; hipLaunchKernelGGL(mk_fwd, dim3(grid), dim3(512), LDS_BYTES, stream, a); } }
}
```

```cpp
#include <hip/hip_runtime.h>
#include <cstdio>
#include <cstdint>

#ifndef MK_N_LAUNCHES
#define MK_N_LAUNCHES 1
#endif

#define DI __device__ __forceinline__
#define LAS __attribute__((address_space(3)))
#define GAS __attribute__((address_space(1)))
typedef unsigned short bf16_t;
typedef short bf16x8 __attribute__((ext_vector_type(8)));
typedef float f32x4 __attribute__((ext_vector_type(4)));
typedef float f32x2 __attribute__((ext_vector_type(2)));
typedef float f32x16 __attribute__((ext_vector_type(16)));
typedef unsigned u32x4 __attribute__((ext_vector_type(4)));
typedef unsigned u32x2 __attribute__((ext_vector_type(2)));
typedef __bf16 bf16x2_t __attribute__((ext_vector_type(2)));
typedef GAS unsigned gu32;
#define RLX_AGENT __ATOMIC_RELAXED, __HIP_MEMORY_SCOPE_AGENT

constexpr int T_TOK = 65536, DM = 1024, DIN = 2304, SEQ = 4096, NBATCH = 16, MEMLEN = 256, NMEM = NBATCH * MEMLEN;
constexpr int NEXP = 64, TOPK = 8, DEXP = 256, CAP = 65536;
constexpr float RMS_EPS = 1e-6f;
constexpr int COL_Q = 0, COL_K = 512, COL_V = 1024, COL_XRG = 1536, COL_GRG = 1792, COL_QCA = 2048;
constexpr int NPHASE = 9;

constexpr size_t MiB = 1u << 20;
constexpr size_t WS_CTL = 0, CTL_ZERO_BYTES = 1 * MiB;
constexpr size_t WS_RINV1 = 1 * MiB, WS_RINV2 = 1 * MiB + 256 * 1024, WS_SEG = 2 * MiB, WS_WRHI = 3 * MiB, WS_WRLO = 3 * MiB + 128 * 1024, WS_RGW = 3 * MiB + 256 * 1024, WS_GATEW = 4 * MiB;
constexpr size_t WS_W1T = 8 * MiB, WS_W2T = 13 * MiB, WS_WMT = 15 * MiB, WS_WGU = 16 * MiB, WS_WD = 81 * MiB;
constexpr size_t WS_MEMN = 114 * MiB, WS_KVM = 122 * MiB, WS_EXPL = 128 * MiB;
constexpr size_t WS_PROJ = 144 * MiB, WS_HID = 144 * MiB;
constexpr size_t WS_XB = 440 * MiB, WS_X1B = 440 * MiB, WS_O = 568 * MiB, WS_Y8 = 440 * MiB, WS_END = 952 * MiB;
constexpr int CW_TMO = 0, CW_BAR = 4096, CW_CNT = 16384;

constexpr int RING_BYTES = 131072, LDSCTL_OFF = RING_BYTES, MISC_OFF = LDSCTL_OFF + 320, TOFF_OFF = LDSCTL_OFF + 1024, LCNT_OFF = TOFF_OFF + 512, TAB_OFF = LDSCTL_OFF + 2048;
constexpr int LDS_BYTES = 147456;

DI unsigned pk2(float lo, float hi) { f32x2 v = {lo, hi}; return __builtin_bit_cast(unsigned, __builtin_convertvector(v, bf16x2_t)); }
DI float bf2f(unsigned short b) { return __uint_as_float((unsigned)b << 16); }
DI bf16_t f2bf(float f) { return (bf16_t)(pk2(f, 0.f) & 0xffffu); }
DI float bflo(unsigned w) { return __uint_as_float(w << 16); }
DI float bfhi(unsigned w) { return __uint_as_float(w & 0xffff0000u); }
DI float wave_sum(float v) {
#pragma unroll
    for (int o = 1; o < 64; o <<= 1) v += __shfl_xor(v, o);
    return v;
}
DI int crow(int r, int h) { return (r & 3) + 8 * (r >> 2) + 4 * h; }
DI float sigmoidf_(float v) { return 1.f / (1.f + __expf(-v)); }
#define MFMA32(a, b, c) __builtin_amdgcn_mfma_f32_32x32x16_bf16((a), (b), (c), 0, 0, 0)
#define MFMA16(a, b, c) __builtin_amdgcn_mfma_f32_16x16x32_bf16((a), (b), (c), 0, 0, 0)
#define LDS_WAIT() asm volatile("s_waitcnt lgkmcnt(0)" ::: "memory")
#define VM_WAIT() asm volatile("s_waitcnt vmcnt(0)" ::: "memory")

#define XB_TMO      128
#define XB_XCNT(j)  (256  + 64 * (j))
#define XB_XSUB(j)  (1280 + 64 * (j))
#define XB_XGEN(j)  (2304 + 64 * (j))
#define XB_TOP      3328
#define XB_TOPGEN   3392
#define XCD_BAR_WORDS 3456
#define XB_SPIN_CAP (1u << 18)
DI unsigned xb_ld(unsigned* p)              { return __hip_atomic_load(p, __ATOMIC_RELAXED, __HIP_MEMORY_SCOPE_AGENT); }
DI unsigned xb_add(unsigned* p, unsigned v) { return __hip_atomic_fetch_add(p, v, __ATOMIC_RELAXED, __HIP_MEMORY_SCOPE_AGENT); }
DI unsigned xb_xcc_id() { return (unsigned)__builtin_amdgcn_s_getreg((3 << 11) | 20) & 0xFu; }
#define XB_SPIN(cond, bar) do { unsigned _sp = 0; while (cond) { __builtin_amdgcn_s_sleep(1); \
    if ((++_sp & 255u) == 0u) { if (xb_ld(&(bar)[XB_TMO])) break; if (_sp > XB_SPIN_CAP) { atomicAdd(&(bar)[XB_TMO], 1u); break; } } } } while (0)
struct XcdBarrier { unsigned* bar; unsigned x; volatile LAS unsigned* st; };
DI XcdBarrier xcd_barrier_post(unsigned* bar, volatile LAS unsigned* st) {
    XcdBarrier b; b.bar = bar; b.x = xb_xcc_id(); b.st = st;
    if (threadIdx.x == 0) (void)xb_add(&bar[XB_XCNT(b.x)], 1u);
    return b;
}
DI void xcd_barrier_complete(unsigned* bar, unsigned x, unsigned& nloc, unsigned& nx) {
    const unsigned G = gridDim.x * gridDim.y * gridDim.z;
    unsigned sum, cnt, mine, sp = 0u;
    for (;;) {
        sum = 0u; cnt = 0u; mine = 0u;
#pragma unroll
        for (unsigned j = 0; j < 16; ++j) { const unsigned c = xb_ld(&bar[XB_XCNT(j)]); sum += c; cnt += (c > 0u) ? 1u : 0u; mine = (j == x) ? c : mine; }
        if (sum == G) break;
        __builtin_amdgcn_s_sleep(1);
        if ((++sp & 255u) == 0u) { if (xb_ld(&bar[XB_TMO])) break; if (sp > XB_SPIN_CAP) { atomicAdd(&bar[XB_TMO], 1u); break; } }
    }
    nloc = mine > 0u ? mine : 1u; nx = cnt > 0u ? cnt : 1u;
}
DI void xcd_barrier(const XcdBarrier& b) {
    asm volatile("s_waitcnt vmcnt(0)" ::: "memory");
    __syncthreads();
    if (threadIdx.x == 0) {
        unsigned* bar = b.bar;
        __builtin_amdgcn_s_waitcnt(0);
        unsigned nloc = b.st[0], nx = b.st[1];
        if (nloc == 0u) { xcd_barrier_complete(bar, b.x, nloc, nx); b.st[0] = nloc; b.st[1] = nx; }
        const unsigned old = xb_add(&bar[XB_XSUB(b.x)], 1u);
        const unsigned gen = old / nloc;
        if (old + 1u == (gen + 1u) * nloc) {
            __builtin_amdgcn_fence(__ATOMIC_RELEASE, "agent");
            asm volatile("s_waitcnt vmcnt(0)" ::: "memory");
            const unsigned og = xb_add(&bar[XB_TOP], 1u);
            const unsigned tg = og / nx;
            if (og + 1u == (tg + 1u) * nx) xb_add(&bar[XB_TOPGEN], 1u);
            else XB_SPIN(xb_ld(&bar[XB_TOPGEN]) == tg, bar);
            __builtin_amdgcn_fence(__ATOMIC_ACQUIRE, "agent");
            xb_add(&bar[XB_XGEN(b.x)], 1u);
            asm volatile("s_waitcnt vmcnt(0)" ::: "memory");
        } else {
            XB_SPIN(xb_ld(&bar[XB_XGEN(b.x)]) == gen, bar);
            __builtin_amdgcn_fence(__ATOMIC_ACQUIRE, "agent");
            asm volatile("s_waitcnt vmcnt(0)" ::: "memory");
        }
    }
    __syncthreads();
}

namespace pg8 {
constexpr int BM = 256, BK = 64, HALF = 128, HTB = HALF * BK * 2, STAGE_BYTES = 8 * HTB, NXCD = 8, WGM = 8;
__host__ __device__ __forceinline__ int lds_byte(int r, int c) { const int st = (r >> 4) * 2 + (c >> 5), rr = r & 15, cc = c & 31, ob = rr * 64 + cc * 2; return st * 1024 + (ob ^ (((ob >> 9) & 1) << 5)); }
__host__ __device__ __forceinline__ void stage_rc(int b, int& R, int& C) { const int st = b / 1024, sb = b % 1024, swz = sb ^ (((sb >> 9) & 1) << 5); R = (st >> 1) * 16 + swz / 64; C = (st & 1) * 32 + (swz % 64) / 2; }
__host__ __device__ __forceinline__ int perm32(int rho) { const int n = rho >> 4, i = rho & 15; return 8 * (i >> 2) + 4 * n + (i & 3); }

template <class Epi, class Sched>
DI void gemm_phase(LAS unsigned char* lds, LAS unsigned* tab  , const char* Abase, const int K, const Sched& S, const Epi& E) {
    typedef typename Sched::Unit Unit;
    const int tid = threadIdx.x, wid = __builtin_amdgcn_readfirstlane(tid >> 6), lane = tid & 63, wr = wid >> 2, wc = wid & 3, fr = lane & 15, fq = lane >> 4;
    const int nt = K / BK;
    int Rr[2]; unsigned Cc[2], voffB[2];
#pragma unroll
    for (int i = 0; i < 2; ++i) { int R, C; stage_rc(tid * 16 + i * 8192, R, C); const int Rb = Epi::PERM ? ((R & ~31) + perm32(R & 31)) : R;
        Rr[i] = R; Cc[i] = (unsigned)C * 2u; voffB[i] = (unsigned)(Rb * K + C) * 2u; }
    const size_t kstep = (size_t)(BK * 2);
    const size_t hstepB = (size_t)HALF * K * 2;
    const unsigned ldsw = (unsigned)wid * 1024u;
    const int aoff = lds_byte(wr * 64 + fr, fq * 8), boff = lds_byte(wc * 32 + fr, fq * 8);
#define PG8_SA(b, h) (((b) * 2 + (h)) * HTB)
#define PG8_SB(b, h) ((4 + (b) * 2 + (h)) * HTB)
#define PG8_STAGE_B(bufoff, gbase) do { _Pragma("unroll") for (int _i = 0; _i < 2; ++_i) \
        __builtin_amdgcn_global_load_lds((const unsigned*)((const char*)(gbase) + voffB[_i]), (LAS unsigned*)(lds + (bufoff) + ldsw + _i * 8192), 16, 0, 0); } while (0)
#define PG8_STAGE_A(bufoff, slot, h, kb) do { _Pragma("unroll") for (int _i = 0; _i < 2; ++_i) \
        __builtin_amdgcn_global_load_lds((const unsigned*)(Abase + (size_t)(tab[(slot) * 256 + (h) * HALF + Rr[_i]] + Cc[_i]) + (size_t)(kb)), (LAS unsigned*)(lds + (bufoff) + ldsw + _i * 8192), 16, 0, 0); } while (0)
#define PG8_FILL(slot, unit) do { if (tid < 256) tab[(slot) * 256 + tid] = S.arow(unit, tid); } while (0)
#define PG8_LDA(dst, b, h) do { _Pragma("unroll") for (int m = 0; m < 4; ++m) _Pragma("unroll") for (int k = 0; k < 2; ++k) dst[m][k] = *(const LAS bf16x8*)(lds + PG8_SA(b, h) + aoff + m * 2048 + k * 1024); } while (0)
#define PG8_LDB(dst, b, h) do { _Pragma("unroll") for (int n = 0; n < 2; ++n) _Pragma("unroll") for (int k = 0; k < 2; ++k) dst[n][k] = *(const LAS bf16x8*)(lds + PG8_SB(b, h) + boff + n * 2048 + k * 1024); } while (0)
#define PG8_MMA(ai, bj, At, Bt) do { __builtin_amdgcn_s_setprio(1); _Pragma("unroll") for (int m = 0; m < 4; ++m) _Pragma("unroll") for (int n = 0; n < 2; ++n) _Pragma("unroll") for (int k = 0; k < 2; ++k) \
        acc[ai][bj][m][n] = __builtin_amdgcn_mfma_f32_16x16x32_bf16(Bt[n][k], At[m][k], acc[ai][bj][m][n], 0, 0, 0); __builtin_amdgcn_s_setprio(0); } while (0)
#define PG8_WAIT_V(n) asm volatile("s_waitcnt vmcnt(" #n ")" ::: "memory")
#define PG8_WAIT_L(n) asm volatile("s_waitcnt lgkmcnt(" #n ")" ::: "memory")
#define PG8_BAR __builtin_amdgcn_s_barrier()
#define PG8_SCHED __builtin_amdgcn_sched_barrier(0)
    Unit cur, nxt; int ui = 0;
    if (!S.next(0, cur)) return;
    f32x4 acc[2][2][4][2];
#pragma unroll
    for (int a = 0; a < 2; ++a)
#pragma unroll
        for (int b = 0; b < 2; ++b)
#pragma unroll
            for (int m = 0; m < 4; ++m)
#pragma unroll
                for (int n = 0; n < 2; ++n) acc[a][b][m][n] = (f32x4){0.f, 0.f, 0.f, 0.f};
    bf16x8 At[4][2], B0[2][2], B1[2][2];
    const char* cB = S.bbase(cur);
    int cs = 0;
    PG8_FILL(0, cur);
    PG8_WAIT_L(0); PG8_BAR; asm volatile("" ::: "memory");
    PG8_STAGE_B(PG8_SB(0, 0), cB); PG8_STAGE_B(PG8_SB(0, 1), cB + hstepB); PG8_STAGE_A(PG8_SA(0, 0), cs, 0, 0); PG8_STAGE_A(PG8_SA(0, 1), cs, 1, 0);
    if (wr == 1) PG8_BAR;
    PG8_WAIT_V(2); PG8_BAR;
    PG8_STAGE_B(PG8_SB(1, 0), cB + kstep); PG8_STAGE_A(PG8_SA(1, 0), cs, 0, kstep); PG8_STAGE_B(PG8_SB(1, 1), cB + hstepB + kstep);
    PG8_WAIT_V(6); PG8_BAR;
    for (;;) {
        const bool has_next = S.next(ui + 1, nxt);
        const char* nB = has_next ? S.bbase(nxt) : cB;
        const int ns = has_next ? (cs ^ 1) : cs;
        if (has_next) PG8_FILL(ns, nxt);
        for (int t = 0; t < nt; t += 2) {
            const bool last = (t == nt - 2);
            const size_t k1 = (size_t)(t + 1) * kstep;
            const int v2 = last ? ns : cs;
            const size_t k2 = last ? (size_t)0 : (size_t)(t + 2) * kstep, k3 = k2 + kstep;
            const char* b2 = last ? nB : cB + (size_t)(t + 2) * kstep; const char* b3 = b2 + kstep;
            PG8_LDB(B0, 0, 0); PG8_LDB(B1, 0, 1); PG8_SCHED; PG8_LDA(At, 0, 0); PG8_STAGE_A(PG8_SA(1, 1), cs, 1, k1);
            PG8_WAIT_V(8); PG8_WAIT_L(0); PG8_BAR; PG8_MMA(0, 0, At, B0); PG8_MMA(0, 1, At, B1); PG8_BAR; PG8_SCHED;
            PG8_LDA(At, 0, 1); PG8_STAGE_B(PG8_SB(0, 0), b2); PG8_STAGE_B(PG8_SB(0, 1), b2 + hstepB); PG8_STAGE_A(PG8_SA(0, 0), v2, 0, k2);
            PG8_WAIT_V(8); PG8_WAIT_L(0); PG8_BAR; PG8_MMA(1, 0, At, B0); PG8_MMA(1, 1, At, B1); PG8_BAR; PG8_SCHED;
            PG8_LDB(B0, 1, 0); PG8_LDB(B1, 1, 1); PG8_SCHED; PG8_LDA(At, 1, 0); PG8_STAGE_A(PG8_SA(0, 1), v2, 1, k2);
            PG8_WAIT_V(8); PG8_WAIT_L(0); PG8_BAR; PG8_MMA(0, 0, At, B0); PG8_MMA(0, 1, At, B1); PG8_BAR; PG8_SCHED;
            PG8_LDA(At, 1, 1); PG8_STAGE_B(PG8_SB(1, 0), b3); PG8_STAGE_B(PG8_SB(1, 1), b3 + hstepB); PG8_STAGE_A(PG8_SA(1, 0), v2, 0, k3);
            PG8_WAIT_V(8); PG8_WAIT_L(0); PG8_BAR; PG8_MMA(1, 0, At, B0); PG8_MMA(1, 1, At, B1); PG8_BAR; PG8_SCHED;
        }
        if (wr == 0) PG8_BAR;
        E(acc, cur, wr, wc, fr, fq);
        if (!has_next) break;
#pragma unroll
        for (int a = 0; a < 2; ++a)
#pragma unroll
            for (int b = 0; b < 2; ++b)
#pragma unroll
                for (int m = 0; m < 4; ++m)
#pragma unroll
                    for (int n = 0; n < 2; ++n) acc[a][b][m][n] = (f32x4){0.f, 0.f, 0.f, 0.f};
        cur = nxt; cB = nB; cs = ns; ++ui;
        if (wr == 1) PG8_BAR;
    }
    PG8_WAIT_V(0);
    PG8_BAR;
#undef PG8_SA
#undef PG8_SB
#undef PG8_STAGE_A
#undef PG8_FILL
#undef PG8_STAGE_B
#undef PG8_LDA
#undef PG8_LDB
#undef PG8_MMA
#undef PG8_WAIT_V
#undef PG8_WAIT_L
#undef PG8_BAR
#undef PG8_SCHED
}

struct SchedStatic {
    struct Unit { int pm, pn; };
    int nM, nN, nwg, G, c, K; const char* Bt;
    DI void init(int M, int N, int K_, int G_, int c_, const void* Bt_) { nM = M / BM; nN = N / BM; nwg = nM * nN; G = G_; c = c_; K = K_; Bt = (const char*)Bt_; }
    DI bool next(int i, Unit& u) const {
        const long L = (long)i * G + c; if (L >= nwg) return false;
        int wgid = (int)L; { const int q = nwg / NXCD, r = nwg % NXCD, xcd = wgid % NXCD, off = wgid / NXCD; wgid = (xcd < r ? xcd * (q + 1) : r * (q + 1) + (xcd - r) * q) + off; }
        const int nig = WGM * nN, gid = wgid / nig, fm = gid * WGM, gsz = (nM - fm) < WGM ? (nM - fm) : WGM;
        u.pm = fm + ((wgid % nig) % gsz); u.pn = (wgid % nig) / gsz; return true;
    }
    DI unsigned arow(const Unit& u, int R) const { return (unsigned)((u.pm * BM + R) * K) * 2u; }
    DI const char* bbase(const Unit& u) const { return Bt + (size_t)u.pn * BM * K * 2; }
};
struct MoeUnit { int e, tile, sub, gt, nvalid; };
DI void moe_find(const LAS int* toff, const LAS int* lcnt, int rt, MoeUnit& u) {
    int lo = 0, hi = 64;
    while (lo < hi) { const int mid = (lo + hi + 1) >> 1; const int v = __builtin_amdgcn_readfirstlane(toff[mid]); if (v <= rt) lo = mid; else hi = mid - 1; }
    u.e = lo; u.tile = rt - __builtin_amdgcn_readfirstlane(toff[lo]); u.gt = rt;
    const int rem = __builtin_amdgcn_readfirstlane(lcnt[lo]) - u.tile * 256; u.nvalid = rem < 256 ? rem : 256;
}
struct SchedGU {
    typedef MoeUnit Unit;
    const LAS int* toff; const LAS int* lcnt; int total, G, c; const int* explist; const char* W;
    DI bool next(int i, Unit& u) const { const int L = i * G + c; if (L >= total) return false; u.sub = L & 1; moe_find(toff, lcnt, L >> 1, u); return true; }
    DI unsigned arow(const Unit& u, int R) const {
        int tok;
        if (u.e == NEXP) tok = u.tile * 256 + R;
        else { const int rr = R < u.nvalid ? R : 0; tok = explist[(size_t)u.e * CAP + u.tile * 256 + rr] >> 3; }
        return (unsigned)tok * (unsigned)(DM * 2);
    }
    DI const char* bbase(const Unit& u) const { return W + ((size_t)u.e * 512 + u.sub * 256) * (DM * 2); }
};
struct SchedDown {
    typedef MoeUnit Unit;
    const LAS int* toff; const LAS int* lcnt; int rt_lo, rt_hi, G, c; const char* W;
    DI bool next(int i, Unit& u) const { const int L = i * G + c; const int rt = rt_lo + (L >> 2); if (rt >= rt_hi) return false; u.sub = L & 3; moe_find(toff, lcnt, rt, u); return true; }
    DI unsigned arow(const Unit& u, int R) const { return (unsigned)(u.gt * 256 + R) * (unsigned)(DEXP * 2); }
    DI const char* bbase(const Unit& u) const { return W + ((size_t)u.e * 1024 + u.sub * 256) * (DEXP * 2); }
};

struct EpiRowScaleBf16 {
    static constexpr bool PERM = true;
    bf16_t* O; int ldc; const float* rs;
    DI void operator()(const f32x4 (&acc)[2][2][4][2], const SchedStatic::Unit& u, int wr, int wc, int fr, int fq) const {
        asm volatile("" : "+v"(fr));
        const int row0 = u.pm * BM + wr * 64 + fr, col0 = u.pn * BM + wc * 32 + 8 * fq;
#pragma unroll
        for (int ai = 0; ai < 2; ++ai)
#pragma unroll
            for (int m = 0; m < 4; ++m) { const int row = row0 + ai * HALF + m * 16; const float sc = rs ? rs[row] : 1.f; bf16_t* rowp = O + (size_t)row * ldc + col0;
#pragma unroll
                for (int bj = 0; bj < 2; ++bj) { const f32x4 v0 = acc[ai][bj][m][0] * sc, v1 = acc[ai][bj][m][1] * sc;
                    u32x4 w; w.x = pk2(v0[0], v0[1]); w.y = pk2(v0[2], v0[3]); w.z = pk2(v1[0], v1[1]); w.w = pk2(v1[2], v1[3]);
                    *(u32x4*)(rowp + bj * HALF) = w; } }
    }
};
struct EpiX1 {
    static constexpr bool PERM = false;
    const float* x; float* out; bf16_t* x1b;
    DI void operator()(const f32x4 (&acc)[2][2][4][2], const SchedStatic::Unit& u, int wr, int wc, int fr, int fq) const {
        asm volatile("" : "+v"(fr));
        const int row0 = u.pm * BM + wr * 64 + fr, col0 = u.pn * BM + wc * 32 + 4 * fq;
#pragma unroll
        for (int ai = 0; ai < 2; ++ai)
#pragma unroll
            for (int m = 0; m < 4; ++m) { const size_t rb = (size_t)(row0 + ai * HALF + m * 16) * DM + col0;
#pragma unroll
                for (int bj = 0; bj < 2; ++bj)
#pragma unroll
                    for (int n = 0; n < 2; ++n) { const size_t off = rb + bj * HALF + n * 16; const f32x4 v = *(const f32x4*)(x + off) + acc[ai][bj][m][n];
                        *(f32x4*)(out + off) = v; u32x2 w; w.x = pk2(v[0], v[1]); w.y = pk2(v[2], v[3]); *(u32x2*)(x1b + off) = w; }
                if (m & 1) asm volatile("" ::: "memory"); }
    }
};
struct EpiGU {
    static constexpr bool PERM = true;
    const int* explist; const float* rinv2; bf16_t* hid;
    DI void operator()(const f32x4 (&acc)[2][2][4][2], const MoeUnit& u, int wr, int wc, int fr, int fq) const {
        asm volatile("" : "+v"(fr));
#pragma unroll
        for (int ai = 0; ai < 2; ++ai)
#pragma unroll
            for (int m = 0; m < 4; ++m) { const int r = ai * HALF + wr * 64 + m * 16 + fr;
                int tok;
                if (u.e == NEXP) tok = u.tile * 256 + r;
                else { const int rr = r < u.nvalid ? r : 0; tok = explist[(size_t)u.e * CAP + u.tile * 256 + rr] >> 3; }
                const float rs = rinv2[tok];
                float hv[8];
#pragma unroll
                for (int n = 0; n < 2; ++n)
#pragma unroll
                    for (int q = 0; q < 4; ++q) { const float g = acc[ai][0][m][n][q] * rs, uu = acc[ai][1][m][n][q] * rs; hv[n * 4 + q] = g * sigmoidf_(g) * uu; }
                u32x4 w; w.x = pk2(hv[0], hv[1]); w.y = pk2(hv[2], hv[3]); w.z = pk2(hv[4], hv[5]); w.w = pk2(hv[6], hv[7]);
                *(u32x4*)(hid + ((size_t)u.gt * 256 + r) * DEXP + u.sub * 128 + wc * 32 + 8 * fq) = w;
                asm volatile("" ::: "memory"); }
    }
};
DI unsigned pk4_fp8(float a, float b, float c, float d) { int w = __builtin_amdgcn_cvt_pk_fp8_f32(a, b, 0, false); w = __builtin_amdgcn_cvt_pk_fp8_f32(c, d, w, true); return (unsigned)w; }
struct EpiDownR {
    static constexpr bool PERM = true;
    const int* explist; const float* gatew; unsigned char* y8;
    DI void operator()(const f32x4 (&acc)[2][2][4][2], const MoeUnit& u, int wr, int wc, int fr, int fq) const {
        asm volatile("" : "+v"(fr));
#pragma unroll
        for (int ai = 0; ai < 2; ++ai)
#pragma unroll
            for (int m = 0; m < 4; ++m) { const int r = ai * HALF + wr * 64 + m * 16 + fr;
                if (r < u.nvalid) { const int p = explist[(size_t)u.e * CAP + u.tile * 256 + r]; const float gw = gatew[p] * 8.f;
                    unsigned char* rowp = y8 + (size_t)p * DM + u.sub * 256 + wc * 32 + 8 * fq;
#pragma unroll
                    for (int bj = 0; bj < 2; ++bj) { const f32x4 v0 = acc[ai][bj][m][0] * gw, v1 = acc[ai][bj][m][1] * gw;
                        u32x2 w; w.x = pk4_fp8(v0[0], v0[1], v0[2], v0[3]); w.y = pk4_fp8(v1[0], v1[1], v1[2], v1[3]); *(u32x2*)(rowp + bj * HALF) = w; } }
                asm volatile("" ::: "memory"); }
    }
};
struct EpiDownS {
    static constexpr bool PERM = true;
    float* out;
    DI void operator()(const f32x4 (&acc)[2][2][4][2], const MoeUnit& u, int wr, int wc, int fr, int fq) const {
        asm volatile("" : "+v"(fr));
#pragma unroll
        for (int ai = 0; ai < 2; ++ai)
#pragma unroll
            for (int m = 0; m < 4; ++m) { const int r = ai * HALF + wr * 64 + m * 16 + fr; float* rowp = out + ((size_t)u.tile * 256 + r) * DM + u.sub * 256 + wc * 32 + 8 * fq;
#pragma unroll
                for (int bj = 0; bj < 2; ++bj)
#pragma unroll
                    for (int n = 0; n < 2; ++n) { float* p = rowp + bj * HALF + 4 * n; *(f32x4*)p = *(const f32x4*)p + acc[ai][bj][m][n]; }
                asm volatile("" ::: "memory"); }
    }
};
}

struct Ctx {
    unsigned char* lds_generic; LAS unsigned char* lds;
    int tid, lane, wid, G, vcu;
    float* out; unsigned char* ws;
};
struct Args { const float* in[28]; float* out; unsigned char* ws; int ph_lo, ph_hi; };

DI const float* in_ptr(int i) {
    const __attribute__((address_space(4))) char* ka = (const __attribute__((address_space(4))) char*)__builtin_amdgcn_kernarg_segment_ptr();
    unsigned off = (unsigned)i * 8u; asm volatile("" : "+s"(off));
    return *(const float* const __attribute__((address_space(4)))*)(ka + off);
}
DI void tr_item(const float* W, int ldn, int k0, int n0, bf16_t* WT, size_t drow0, int ldk, const float* scale, LAS float* scr, int lane) {
#pragma unroll 8
    for (int i = 0; i < 32; ++i) { const int kk = 2 * i + (lane >> 5); const float s = scale ? scale[kk] : 1.f; scr[kk * 33 + (lane & 31)] = W[(size_t)(k0 + kk) * ldn + n0 + (lane & 31)] * s; }
    LDS_WAIT(); asm volatile("" ::: "memory");
    const int c = lane & 7;
#pragma unroll
    for (int j = 0; j < 4; ++j) { const int n = (lane >> 3) + 8 * j; const LAS float* s = scr + (8 * c) * 33 + n;
        u32x4 o; o.x = pk2(s[0 * 33], s[1 * 33]); o.y = pk2(s[2 * 33], s[3 * 33]); o.z = pk2(s[4 * 33], s[5 * 33]); o.w = pk2(s[6 * 33], s[7 * 33]);
        *(u32x4*)(WT + (drow0 + n) * (size_t)ldk + k0 + 8 * c) = o; }
    LDS_WAIT(); asm volatile("" ::: "memory");
}
DI void p0_prologue(const Ctx& C) {
    LAS float* scr = (LAS float*)(C.lds + C.wid * 16384);
    const int gw = C.vcu * 8 + C.wid, NGW = C.G * 8, lane = C.lane;
    bf16_t* W1T = (bf16_t*)(C.ws + WS_W1T); bf16_t* W2T = (bf16_t*)(C.ws + WS_W2T); bf16_t* WMT = (bf16_t*)(C.ws + WS_WMT);
    bf16_t* WGU = (bf16_t*)(C.ws + WS_WGU); bf16_t* WD = (bf16_t*)(C.ws + WS_WD);
    constexpr int I_IN = 16 * 72, I_OUT = 16 * 32, I_MEM = 16 * 16, I_G = 16 * 8, I_D = 4 * 32;
    constexpr int NITEMS = I_IN + I_OUT + I_MEM + 65 * (2 * I_G + I_D);
    for (int it = gw; it < NITEMS; it += NGW) {
        int r = it;
        if (r < I_IN) { const int kb = r / 72, nb = r % 72; tr_item(in_ptr(4), DIN, 64 * kb, 32 * nb, W1T, (size_t)32 * nb, DM, in_ptr(2) + 64 * kb, scr, lane); continue; } r -= I_IN;
        if (r < I_OUT) { const int kb = r / 32, nb = r % 32, k0 = 64 * kb; const float* sc = k0 < 512 ? in_ptr(15) + k0 : (k0 < 768 ? in_ptr(16) + (k0 - 512) : in_ptr(17) + (k0 - 768));
            tr_item(in_ptr(18), DM, k0, 32 * nb, W2T, (size_t)32 * nb, DM, sc, scr, lane); continue; } r -= I_OUT;
        if (r < I_MEM) { const int kb = r / 16, nb = r % 16; tr_item(in_ptr(12), 512, 64 * kb, 32 * nb, WMT, (size_t)32 * nb, DM, in_ptr(3) + 64 * kb, scr, lane); continue; } r -= I_MEM;
        const int e = r / (2 * I_G + I_D); r -= e * (2 * I_G + I_D);
        if (r < 2 * I_G) { const int up = r >= I_G; if (up) r -= I_G; const int kb = r / 8, nb = r % 8, n0 = 32 * nb;
            const float* src = e < NEXP ? (up ? in_ptr(23) : in_ptr(22)) + (size_t)e * DM * DEXP : (up ? in_ptr(26) : in_ptr(25));
            const size_t drow0 = (size_t)e * 512 + (n0 >> 7) * 256 + (up ? 128 : 0) + (n0 & 127);
            tr_item(src, DEXP, 64 * kb, n0, WGU, drow0, DM, in_ptr(19) + 64 * kb, scr, lane); continue; }
        r -= 2 * I_G;
        { const int kb = r / 32, nb = r % 32; const float* src = e < NEXP ? in_ptr(24) + (size_t)e * DEXP * DM : in_ptr(27);
          tr_item(src, DM, 64 * kb, 32 * nb, WD, (size_t)e * 1024 + 32 * nb, DEXP, nullptr, scr, lane); }
    }
    { bf16_t* WRH = (bf16_t*)(C.ws + WS_WRHI); bf16_t* WRL = (bf16_t*)(C.ws + WS_WRLO);
      for (int idx = (C.vcu * 512 + C.tid); idx < DM * NEXP; idx += C.G * 512) { const int k = idx >> 6, n = idx & 63; const float v = in_ptr(20)[idx] * in_ptr(19)[k];
          const bf16_t h = f2bf(v); const bf16_t l = f2bf(v - bf2f(h)); WRH[n * DM + k] = h; WRL[n * DM + k] = l; } }
    { u32x4* RGW = (u32x4*)(C.ws + WS_RGW);
      for (int idx = C.vcu * 512 + C.tid; idx < 2 * 4 * 8 * 64; idx += C.G * 512) { const int ln = idx & 63, f = (idx >> 6) & 7, n = (idx >> 9) & 3, mat = idx >> 11; const int nb = f >> 1, kc = f & 1;
          const float* w = (mat ? in_ptr(9) : in_ptr(7)) + (size_t)n * 4096; const int c0 = 32 * kc + 8 * (ln >> 4), d = 16 * nb + (ln & 15);
          u32x4 o; o.x = pk2(w[(c0 + 0) * 64 + d], w[(c0 + 1) * 64 + d]); o.y = pk2(w[(c0 + 2) * 64 + d], w[(c0 + 3) * 64 + d]); o.z = pk2(w[(c0 + 4) * 64 + d], w[(c0 + 5) * 64 + d]); o.w = pk2(w[(c0 + 6) * 64 + d], w[(c0 + 7) * 64 + d]);
          RGW[idx] = o; } }
    { bf16_t* XB = (bf16_t*)(C.ws + WS_XB); float* R1 = (float*)(C.ws + WS_RINV1); bf16_t* MN = (bf16_t*)(C.ws + WS_MEMN);
      for (int m = gw; m < T_TOK + NMEM; m += NGW) {
          const bool ismem = m >= T_TOK; const float* src = ismem ? in_ptr(1) + (size_t)(m - T_TOK) * DM : in_ptr(0) + (size_t)m * DM;
          const f32x4* xr = (const f32x4*)src + lane; f32x4 v[4]; float s = 0.f;
#pragma unroll
          for (int j = 0; j < 4; ++j) { v[j] = xr[64 * j]; s += (v[j].x * v[j].x + v[j].y * v[j].y) + (v[j].z * v[j].z + v[j].w * v[j].w); }
          const float rinv = 1.0f / sqrtf(wave_sum(s) * (1.f / DM) + RMS_EPS);
          const float mul = ismem ? rinv : 1.f;
          bf16_t* dst = ismem ? MN + (size_t)(m - T_TOK) * DM : XB + (size_t)m * DM;
          u32x2* o8 = (u32x2*)dst + lane;
#pragma unroll
          for (int j = 0; j < 4; ++j) { u32x2 w; w.x = pk2(v[j].x * mul, v[j].y * mul); w.y = pk2(v[j].z * mul, v[j].w * mul); o8[64 * j] = w; }
          if (!ismem && lane == 0) R1[m] = rinv;
      } }
}

DI void stage_v(const bf16_t* gsrc, size_t pitch, LAS bf16_t* vs, int lane) {
    const int row = lane >> 1, c0 = (lane & 1) * 32;
    const u32x4* src = (const u32x4*)(gsrc + (size_t)row * pitch + c0);
    const u32x4 v0 = src[0], v1 = src[1], v2 = src[2], v3 = src[3];
    LAS u32x4* dst = (LAS u32x4*)(vs + row * 72 + c0);
    dst[0] = v0; dst[1] = v1; dst[2] = v2; dst[3] = v3;
}
DI void sb_unit(const bf16_t* proj, bf16_t* obuf, LAS bf16_t* vs, int b, int hd, int qb, int wid, int lane) {
    const int r = lane & 31, h = lane >> 5;
    const int t0 = qb * 256 + wid * 32;
    const size_t rowb = (size_t)b * SEQ;
    bf16x8 qf[4];
    { const bf16_t* qp = proj + (rowb + t0 + r) * DIN + COL_Q + hd * 64 + 8 * h;
#pragma unroll
      for (int c = 0; c < 4; ++c) qf[c] = *(const bf16x8*)(qp + 16 * c); }
    f32x16 o0, o1;
#pragma unroll
    for (int i = 0; i < 16; ++i) { o0[i] = 0.f; o1[i] = 0.f; }
    float R = 0.f;
    const int tq = t0 + r;
    for (int kb = t0 >> 5; kb >= 0; --kb) {
        const int s0 = kb * 32;
        bf16x8 kf[4];
        { const bf16_t* kp = proj + (rowb + s0 + r) * DIN + COL_K + hd * 64 + 8 * h;
#pragma unroll
          for (int c = 0; c < 4; ++c) kf[c] = *(const bf16x8*)(kp + 16 * c); }
        stage_v(proj + (rowb + s0) * DIN + COL_V + hd * 64, DIN, vs, lane);
        f32x16 p;
#pragma unroll
        for (int i = 0; i < 16; ++i) p[i] = 0.f;
#pragma unroll
        for (int c = 0; c < 4; ++c) p = MFMA32(kf[c], qf[c], p);
        float z[16], cs[16], Tg[4], Pg[4], Eg[4];
#pragma unroll
        for (int g = 0; g < 4; ++g) {
            float run = 0.f;
#pragma unroll
            for (int j = 3; j >= 0; --j) { const int i = 4 * g + j; const int kv = s0 + crow(i, h); const bool valid = kv < tq;
                const float zz = p[i] * 0.125f; z[i] = zz;
                const float sp = fmaxf(zz, 0.f) + __logf(1.f + __expf(-fabsf(zz)));
                run += valid ? -sp : 0.f; cs[i] = run; }
            Tg[g] = run;
        }
#pragma unroll
        for (int g = 0; g < 4; ++g) Pg[g] = __shfl_xor(Tg[g], 32);
        float after = 0.f;
#pragma unroll
        for (int g = 3; g >= 0; --g) { Eg[g] = after + (h == 0 ? Pg[g] : 0.f); after += Tg[g] + Pg[g]; }
        float w[16];
#pragma unroll
        for (int i = 0; i < 16; ++i) { const int kv = s0 + crow(i, h); const bool valid = kv < tq; const float lw = z[i] + cs[i] + Eg[i >> 2] + R; w[i] = valid ? __expf(lw) : 0.f; }
        R += after;
#pragma unroll
        for (int s = 0; s < 2; ++s) {
            u32x4 xw; xw.x = pk2(w[8 * s + 0], w[8 * s + 1]); xw.y = pk2(w[8 * s + 2], w[8 * s + 3]); xw.z = pk2(w[8 * s + 4], w[8 * s + 5]); xw.w = pk2(w[8 * s + 6], w[8 * s + 7]);
            const bf16x8 xs = __builtin_bit_cast(bf16x8, xw);
#pragma unroll
            for (int dh = 0; dh < 2; ++dh) {
                bf16x8 pb;
#pragma unroll
                for (int j = 0; j < 8; ++j) pb[j] = (short)vs[(16 * s + 8 * (j >> 2) + 4 * h + (j & 3)) * 72 + 32 * dh + r];
                if (dh == 0) o0 = MFMA32(xs, pb, o0); else o1 = MFMA32(xs, pb, o1);
            }
        }
        if (__all(R < -105.f)) break;
    }
#pragma unroll
    for (int i = 0; i < 16; ++i) { bf16_t* op = obuf + (rowb + t0 + crow(i, h)) * DM + hd * 64 + r; op[0] = f2bf(o0[i]); op[32] = f2bf(o1[i]); }
}
DI void ca_unit(const bf16_t* proj, const bf16_t* kvm, const float* qg, const float* kg, bf16_t* obuf, LAS bf16_t* vs, int b, int hd, int qb, int wid, int lane) {
    const int r = lane & 31, h = lane >> 5;
    const int t0 = qb * 256 + wid * 32;
    const size_t rowb = (size_t)b * SEQ;
    bf16x8 qf[4];
    { const bf16_t* qp = proj + (rowb + t0 + r) * DIN + COL_QCA + hd * 64 + 8 * h;
      float qv[4][8]; float ss = 0.f;
#pragma unroll
      for (int c = 0; c < 4; ++c) { const u32x4 raw = *(const u32x4*)(qp + 16 * c);
#pragma unroll
          for (int q = 0; q < 4; ++q) { qv[c][2 * q] = bflo(raw[q]); qv[c][2 * q + 1] = bfhi(raw[q]); ss += qv[c][2 * q] * qv[c][2 * q] + qv[c][2 * q + 1] * qv[c][2 * q + 1]; } }
      ss += __shfl_xor(ss, 32);
      const float rq = (1.0f / sqrtf(ss * (1.f / 64.f) + RMS_EPS)) * 0.125f;
#pragma unroll
      for (int c = 0; c < 4; ++c) { const float* g = qg + 16 * c + 8 * h; u32x4 w;
#pragma unroll
          for (int q = 0; q < 4; ++q) w[q] = pk2(qv[c][2 * q] * rq * g[2 * q], qv[c][2 * q + 1] * rq * g[2 * q + 1]);
          qf[c] = __builtin_bit_cast(bf16x8, w); } }
#define CA_QK(kb, accv) do { const bf16_t* kp = kvm + ((size_t)b * MEMLEN + (kb) * 32 + r) * 512 + hd * 64 + 8 * h; \
        u32x4 raw[4]; float ss_ = 0.f; \
        _Pragma("unroll") for (int c = 0; c < 4; ++c) { raw[c] = *(const u32x4*)(kp + 16 * c); \
            _Pragma("unroll") for (int q = 0; q < 4; ++q) { const float a_ = bflo(raw[c][q]), b_ = bfhi(raw[c][q]); ss_ += a_ * a_ + b_ * b_; } } \
        ss_ += __shfl_xor(ss_, 32); \
        const float rk = 1.0f / sqrtf(ss_ * (1.f / 64.f) + RMS_EPS); \
        _Pragma("unroll") for (int i = 0; i < 16; ++i) accv[i] = 0.f; \
        _Pragma("unroll") for (int c = 0; c < 4; ++c) { const float* g = kg + 16 * c + 8 * h; u32x4 w_; \
            _Pragma("unroll") for (int q = 0; q < 4; ++q) w_[q] = pk2(bflo(raw[c][q]) * rk * g[2 * q], bfhi(raw[c][q]) * rk * g[2 * q + 1]); \
            accv = MFMA32(__builtin_bit_cast(bf16x8, w_), qf[c], accv); } } while (0)
    float mx = -3.0e38f;
    for (int kb = 0; kb < 8; ++kb) {
        f32x16 p; CA_QK(kb, p);
#pragma unroll
        for (int i = 0; i < 16; ++i) mx = fmaxf(mx, p[i]);
    }
    mx = fmaxf(mx, __shfl_xor(mx, 32));
    float l = 0.f;
    f32x16 o0, o1;
#pragma unroll
    for (int i = 0; i < 16; ++i) { o0[i] = 0.f; o1[i] = 0.f; }
    for (int kb = 0; kb < 8; ++kb) {
        stage_v(kvm + ((size_t)b * MEMLEN + kb * 32) * 512 + 256 + hd * 64, 512, vs, lane);
        f32x16 p; CA_QK(kb, p);
#pragma unroll
        for (int i = 0; i < 16; ++i) { const float e = __expf(p[i] - mx); p[i] = e; l += e; }
#pragma unroll
        for (int s = 0; s < 2; ++s) {
            u32x4 xw;
#pragma unroll
            for (int q = 0; q < 4; ++q) xw[q] = pk2(p[8 * s + 2 * q], p[8 * s + 2 * q + 1]);
            const bf16x8 xs = __builtin_bit_cast(bf16x8, xw);
#pragma unroll
            for (int dh = 0; dh < 2; ++dh) {
                bf16x8 pb;
#pragma unroll
                for (int j = 0; j < 8; ++j) pb[j] = (short)vs[(16 * s + 8 * (j >> 2) + 4 * h + (j & 3)) * 72 + 32 * dh + r];
                if (dh == 0) o0 = MFMA32(xs, pb, o0); else o1 = MFMA32(xs, pb, o1);
            }
        }
    }
#undef CA_QK
    l += __shfl_xor(l, 32);
    const float inv = 1.f / l;
#pragma unroll
    for (int i = 0; i < 16; ++i) { const float iv = __shfl(inv, crow(i, h)); bf16_t* op = obuf + (rowb + t0 + crow(i, h)) * DM + 768 + hd * 64 + r; op[0] = f2bf(o0[i] * iv); op[32] = f2bf(o1[i] * iv); }
}
DI float neg_expm1(float x) {
    if (x > -0.25f) { return -x * (1.f + x * (0.5f + x * (0.16666667f + x * (0.041666668f + x * (0.0083333338f + x * 0.0013888889f))))); }
    return 1.f - __expf(x);
}
DI float gelu_tanh(float x) { const float y = 0.7978845608f * (x + 0.044715f * x * x * x); const float t = 1.f - 2.f / (__expf(2.f * y) + 1.f); return 0.5f * x * (1.f + t); }
template <bool PASS2>
DI void rg_wave(const Ctx& C, int b, int chunk, LAS unsigned char* wscr, LAS float* ssq) {
    const int lane = C.lane, n = C.wid & 3, half = C.wid >> 2, ch = 64 * n + lane;
    const bf16_t* proj = (const bf16_t*)(C.ws + WS_PROJ);
    float* seg = (float*)(C.ws + WS_SEG);
    bf16_t* obuf = (bf16_t*)(C.ws + WS_O);
    const int tl0 = half * 128, t_start = chunk * 256 + tl0, sidx = chunk * 2 + half;
    const size_t rowb = (size_t)b * SEQ;
    const float cw0 = in_ptr(5)[0 * 256 + ch], cw1 = in_ptr(5)[1 * 256 + ch], cw2 = in_ptr(5)[2 * 256 + ch], cw3 = in_ptr(5)[3 * 256 + ch], cb = in_ptr(6)[ch];
    const float brg = in_ptr(8)[ch], big = in_ptr(10)[ch];
    const float lam = in_ptr(11)[ch];
    const float c8 = -8.f * (fmaxf(-lam, 0.f) + __logf(1.f + __expf(-fabsf(lam))));
    bf16x8 wrf[4][2], wif[4][2];
    { const bf16x8* fr_ = (const bf16x8*)(C.ws + WS_RGW) + (size_t)(n * 8) * 64 + lane; const bf16x8* fi_ = fr_ + 4 * 8 * 64;
#pragma unroll
      for (int nb = 0; nb < 4; ++nb)
#pragma unroll
          for (int kc = 0; kc < 2; ++kc) { wrf[nb][kc] = fr_[(nb * 2 + kc) * 64]; wif[nb][kc] = fi_[(nb * 2 + kc) * 64]; } }
    float hst = 0.f, aprod = 1.f;
    if (PASS2) {
        const float* sp = seg + ((size_t)b * 32 * 256 + ch) * 2;
#pragma unroll 4
        for (int s = 0; s < sidx; ++s) { const f32x2 v = *(const f32x2*)(sp + (size_t)s * 512); hst = v.x * hst + v.y; }
    }
    float x3 = 0.f, x2 = 0.f, x1 = 0.f;
    if (t_start > 0) { const bf16_t* xp = proj + (rowb + t_start - 3) * DIN + COL_XRG + ch; x3 = bf2f(xp[0]); x2 = bf2f(xp[DIN]); x1 = bf2f(xp[2 * DIN]); }
    LAS bf16_t* At = (LAS bf16_t*)wscr;
    LAS float* Pr = (LAS float*)(wscr + 2304);
    LAS float* Pi = (LAS float*)(wscr + 2304 + 4096);
    LAS float* Xc = (LAS float*)(wscr + 2304 + 8192);
    for (int sub = 0; sub < 8; ++sub) {
        const int tb = t_start + sub * 16;
#pragma unroll 4
        for (int tt = 0; tt < 16; ++tt) { const float x0 = bf2f(proj[(rowb + tb + tt) * DIN + COL_XRG + ch]);
            const float v = cb + cw0 * x3 + cw1 * x2 + cw2 * x1 + cw3 * x0; Xc[tt * 64 + lane] = v; x3 = x2; x2 = x1; x1 = x0; At[tt * 72 + lane] = f2bf(v); }
        LDS_WAIT(); asm volatile("" ::: "memory");
        bf16x8 af[2];
#pragma unroll
        for (int kc = 0; kc < 2; ++kc) af[kc] = *(const LAS bf16x8*)(At + (lane & 15) * 72 + 32 * kc + 8 * (lane >> 4));
#pragma unroll
        for (int nb = 0; nb < 4; ++nb) { f32x4 ar = {0.f, 0.f, 0.f, 0.f}, ai = {0.f, 0.f, 0.f, 0.f};
#pragma unroll
            for (int kc = 0; kc < 2; ++kc) { ar = MFMA16(af[kc], wrf[nb][kc], ar); ai = MFMA16(af[kc], wif[nb][kc], ai); }
#pragma unroll
            for (int q = 0; q < 4; ++q) { const int t = 4 * (lane >> 4) + q, d = 16 * nb + (lane & 15); Pr[t * 64 + d] = ar[q]; Pi[t * 64 + d] = ai[q]; } }
        LDS_WAIT(); asm volatile("" ::: "memory");
#pragma unroll 2
        for (int tt = 0; tt < 16; ++tt) {
            const float rr = sigmoidf_(Pr[tt * 64 + lane] + brg), ii = sigmoidf_(Pi[tt * 64 + lane] + big);
            const float la = c8 * rr, a = __expf(la), mult = sqrtf(neg_expm1(2.f * la));
            hst = a * hst + mult * ii * Xc[tt * 64 + lane]; aprod *= a;
            if (PASS2) { const size_t row = rowb + tb + tt; const float gate = bf2f(proj[row * DIN + COL_GRG + ch]); const float o = gelu_tanh(gate) * hst;
                obuf[row * DM + 512 + ch] = f2bf(o); const float s2 = wave_sum(o * o); if (lane == 0) ssq[n * 256 + tl0 + sub * 16 + tt] = s2; }
        }
        LDS_WAIT(); asm volatile("" ::: "memory");
    }
    if (!PASS2) { *(f32x2*)(seg + (((size_t)b * 32 + sidx) * 256 + ch) * 2) = (f32x2){aprod, hst}; }
}
DI void p2_mixers(const Ctx& C) {
    const bf16_t* proj = (const bf16_t*)(C.ws + WS_PROJ); const bf16_t* kvm = (const bf16_t*)(C.ws + WS_KVM); bf16_t* obuf = (bf16_t*)(C.ws + WS_O);
    constexpr int N_RG = 256, N_CA = NBATCH * 4 * 16, N_SB = NBATCH * 8 * 16;
    for (int L = C.vcu; L < N_RG + N_CA + N_SB; L += C.G) {
        if (L < N_RG) { rg_wave<false>(C, L >> 4, L & 15, C.lds + C.wid * 15360, nullptr); }
        else if (L < N_RG + N_CA) { const int u = L - N_RG; const int qb = u & 15, hd = (u >> 4) & 3, b = u >> 6; ca_unit(proj, kvm, in_ptr(13), in_ptr(14), obuf, (LAS bf16_t*)(C.lds + C.wid * 15360), b, hd, qb, C.wid, C.lane); }
        else { const int u = L - N_RG - N_CA; const int qb = u & 15, hd = (u >> 4) & 7, b = u >> 7; sb_unit(proj, obuf, (LAS bf16_t*)(C.lds + C.wid * 15360), b, hd, qb, C.wid, C.lane); }
    }
}
DI void p3_norm(const Ctx& C) {
    bf16_t* obuf = (bf16_t*)(C.ws + WS_O);
    LAS float* ssq = (LAS float*)(C.lds + 122880);
    for (int L = C.vcu; L < 256; L += C.G) {
        const int b = L >> 4, chunk = L & 15;
        rg_wave<true>(C, b, chunk, C.lds + C.wid * 15360, ssq);
        VM_WAIT(); __syncthreads();
        for (int rr = 0; rr < 32; ++rr) {
            const int tl = C.wid * 32 + rr; const size_t row = (size_t)b * SEQ + chunk * 256 + tl; bf16_t* rp = obuf + row * DM; const int lane = C.lane;
            const u32x4 sb = *(const u32x4*)(rp + 8 * lane); const u32x2 rg = *(const u32x2*)(rp + 512 + 4 * lane); const u32x2 ca = *(const u32x2*)(rp + 768 + 4 * lane);
            float vs[8], vr[4], vc[4]; float s_sb = 0.f, s_ca = 0.f;
#pragma unroll
            for (int q = 0; q < 4; ++q) { vs[2 * q] = bflo(sb[q]); vs[2 * q + 1] = bfhi(sb[q]); s_sb += vs[2 * q] * vs[2 * q] + vs[2 * q + 1] * vs[2 * q + 1]; }
#pragma unroll
            for (int q = 0; q < 2; ++q) { vr[2 * q] = bflo(rg[q]); vr[2 * q + 1] = bfhi(rg[q]); vc[2 * q] = bflo(ca[q]); vc[2 * q + 1] = bfhi(ca[q]); s_ca += vc[2 * q] * vc[2 * q] + vc[2 * q + 1] * vc[2 * q + 1]; }
            s_sb = wave_sum(s_sb); s_ca = wave_sum(s_ca);
            const float s_rg = (ssq[tl] + ssq[256 + tl]) + (ssq[512 + tl] + ssq[768 + tl]);
            const float i_sb = 1.0f / sqrtf(s_sb * (1.f / 512.f) + RMS_EPS), i_rg = 1.0f / sqrtf(s_rg * (1.f / 256.f) + RMS_EPS), i_ca = 1.0f / sqrtf(s_ca * (1.f / 256.f) + RMS_EPS);
            u32x4 w; w.x = pk2(vs[0] * i_sb, vs[1] * i_sb); w.y = pk2(vs[2] * i_sb, vs[3] * i_sb); w.z = pk2(vs[4] * i_sb, vs[5] * i_sb); w.w = pk2(vs[6] * i_sb, vs[7] * i_sb);
            *(u32x4*)(rp + 8 * lane) = w;
            u32x2 w2; w2.x = pk2(vr[0] * i_rg, vr[1] * i_rg); w2.y = pk2(vr[2] * i_rg, vr[3] * i_rg); *(u32x2*)(rp + 512 + 4 * lane) = w2;
            u32x2 w3; w3.x = pk2(vc[0] * i_ca, vc[1] * i_ca); w3.y = pk2(vc[2] * i_ca, vc[3] * i_ca); *(u32x2*)(rp + 768 + 4 * lane) = w3;
        }
        __syncthreads();
    }
}
DI void p5_router(const Ctx& C) {
    const float* x1 = C.out; float* rinv2 = (float*)(C.ws + WS_RINV2); float* gatew = (float*)(C.ws + WS_GATEW); int* explist = (int*)(C.ws + WS_EXPL);
    const bf16_t* WRH = (const bf16_t*)(C.ws + WS_WRHI); const bf16_t* WRL = (const bf16_t*)(C.ws + WS_WRLO);
    unsigned* cnt = (unsigned*)(C.ws + WS_CTL) + CW_CNT;
    LAS float* lg = (LAS float*)C.lds;
    LAS int* sel_e = (LAS int*)(C.lds + 66560);
    LAS float* sel_w = (LAS float*)(C.lds + 66560 + 8192);
    LAS int* sel_r = (LAS int*)(C.lds + 66560 + 16384);
    LAS int* lcount = (LAS int*)(C.lds + 66560 + 24576);
    LAS int* lbase = (LAS int*)(C.lds + 66560 + 24576 + 256);
    LAS float* lbias = (LAS float*)(C.lds + 66560 + 24576 + 512);
    const int lane = C.lane, wid = C.wid, tid = C.tid;
    for (int L = C.vcu; L < 256; L += C.G) {
        if (tid < 64) { lcount[tid] = 0; lbias[tid] = in_ptr(21)[tid]; }
        const int tbase = L * 256 + wid * 32;
        f32x4 acc[2][4];
#pragma unroll
        for (int m = 0; m < 2; ++m)
#pragma unroll
            for (int n = 0; n < 4; ++n) acc[m][n] = (f32x4){0.f, 0.f, 0.f, 0.f};
        float ss[2] = {0.f, 0.f};
        const int kq = lane >> 4, l15 = lane & 15;
        for (int k0 = 0; k0 < DM; k0 += 32) {
            bf16x8 ahi[2], alo[2];
#pragma unroll
            for (int m = 0; m < 2; ++m) { const float* p = x1 + (size_t)(tbase + 16 * m + l15) * DM + k0 + 8 * kq; const f32x4 v0 = *(const f32x4*)p, v1 = *(const f32x4*)(p + 4);
                ss[m] += (v0[0] * v0[0] + v0[1] * v0[1]) + (v0[2] * v0[2] + v0[3] * v0[3]) + (v1[0] * v1[0] + v1[1] * v1[1]) + (v1[2] * v1[2] + v1[3] * v1[3]);
                u32x4 hh, ll;
                hh.x = pk2(v0[0], v0[1]); hh.y = pk2(v0[2], v0[3]); hh.z = pk2(v1[0], v1[1]); hh.w = pk2(v1[2], v1[3]);
                ll.x = pk2(v0[0] - bflo(hh.x), v0[1] - bfhi(hh.x)); ll.y = pk2(v0[2] - bflo(hh.y), v0[3] - bfhi(hh.y));
                ll.z = pk2(v1[0] - bflo(hh.z), v1[1] - bfhi(hh.z)); ll.w = pk2(v1[2] - bflo(hh.w), v1[3] - bfhi(hh.w));
                ahi[m] = __builtin_bit_cast(bf16x8, hh); alo[m] = __builtin_bit_cast(bf16x8, ll); }
#pragma unroll
            for (int n = 0; n < 4; ++n) { const size_t wo = (size_t)(16 * n + l15) * DM + k0 + 8 * kq; const bf16x8 bh = *(const bf16x8*)(WRH + wo), bl = *(const bf16x8*)(WRL + wo);
#pragma unroll
                for (int m = 0; m < 2; ++m) { acc[m][n] = MFMA16(bh, ahi[m], acc[m][n]); acc[m][n] = MFMA16(bh, alo[m], acc[m][n]); acc[m][n] = MFMA16(bl, ahi[m], acc[m][n]); } }
        }
#pragma unroll
        for (int m = 0; m < 2; ++m) { float s = ss[m]; s += __shfl_xor(s, 16); s += __shfl_xor(s, 32); const float rinv = 1.0f / sqrtf(s * (1.f / DM) + RMS_EPS);
            const int tl = wid * 32 + 16 * m + l15; if (kq == 0) rinv2[L * 256 + tl] = rinv;
#pragma unroll
            for (int n = 0; n < 4; ++n)
#pragma unroll
                for (int q = 0; q < 4; ++q) lg[tl * 65 + 16 * n + 4 * kq + q] = acc[m][n][q] * rinv; }
        __syncthreads();
        if (tid < 256) {
            LAS float* row = lg + tid * 65;
            for (int e = 0; e < 64; ++e) { const float s = sigmoidf_(row[e]); row[e] = s + lbias[e]; }
            float gs[8];
#pragma unroll
            for (int g = 0; g < 8; ++g) { float m1 = -3.0e38f, m2 = -3.0e38f;
                for (int j = 0; j < 8; ++j) { const float v = row[8 * g + j]; if (v > m1) { m2 = m1; m1 = v; } else if (v > m2) m2 = v; }
                gs[g] = m1 + m2; }
            unsigned gmask = 0u;
#pragma unroll
            for (int it = 0; it < 4; ++it) { float best = -3.0e38f; int bi = 0;
#pragma unroll
                for (int g = 0; g < 8; ++g) { const bool free_ = !((gmask >> g) & 1u); if (free_ && gs[g] > best) { best = gs[g]; bi = g; } }
                gmask |= 1u << bi; }
            unsigned long long chosen = 0ull; float wsum = 0.f;
            for (int k = 0; k < 8; ++k) { float best = -3.0e38f; int be = 0;
                for (int g = 0; g < 8; ++g) { if (!((gmask >> g) & 1u)) continue;
                    for (int j = 0; j < 8; ++j) { const int e = 8 * g + j; if ((chosen >> e) & 1ull) continue; const float v = row[e]; if (v > best) { best = v; be = e; } } }
                chosen |= 1ull << be; const float w = best - lbias[be]; wsum += w; sel_e[tid * 8 + k] = be; sel_w[tid * 8 + k] = w;
                sel_r[tid * 8 + k] = __hip_atomic_fetch_add(lcount + be, 1, __ATOMIC_RELAXED, __HIP_MEMORY_SCOPE_WORKGROUP); }
            const float sc = 2.5f / (wsum + 1e-20f);
            for (int k = 0; k < 8; ++k) sel_w[tid * 8 + k] *= sc;
        }
        __syncthreads();
        if (tid < 64) lbase[tid] = (int)__hip_atomic_fetch_add(cnt + tid, (unsigned)lcount[tid], __ATOMIC_RELAXED, __HIP_MEMORY_SCOPE_AGENT);
        __syncthreads();
        if (tid < 256) { const int tok = L * 256 + tid;
            for (int k = 0; k < 8; ++k) { const int e = sel_e[tid * 8 + k]; const int pos = lbase[e] + sel_r[tid * 8 + k]; explist[(size_t)e * CAP + pos] = tok * 8 + k; gatew[tok * 8 + k] = sel_w[tid * 8 + k]; } }
        __syncthreads();
    }
}
DI void moe_prep(const Ctx& C, LAS int* toff, LAS int* lcnt) {
    unsigned* cnt = (unsigned*)(C.ws + WS_CTL) + CW_CNT;
    if (C.tid < 65) lcnt[C.tid] = C.tid < 64 ? (int)__hip_atomic_load(cnt + C.tid, RLX_AGENT) : T_TOK;
    __syncthreads();
    if (C.tid == 0) { int s = 0; for (int e = 0; e < 65; ++e) { toff[e] = s; s += (lcnt[e] + 255) >> 8; } toff[65] = s; }
    __syncthreads();
}
DI void p8_combine(const Ctx& C) {
    const unsigned char* y8 = C.ws + WS_Y8; float* out = C.out;
    const int gw = C.vcu * 8 + C.wid, NGW = C.G * 8, lane = C.lane;
    for (int tok = gw; tok < T_TOK; tok += NGW) {
        float a[16];
        float* op = out + (size_t)tok * DM + 16 * lane;
#pragma unroll
        for (int q = 0; q < 4; ++q) { const f32x4 v = *(const f32x4*)(op + 4 * q); a[4 * q] = v[0]; a[4 * q + 1] = v[1]; a[4 * q + 2] = v[2]; a[4 * q + 3] = v[3]; }
        float s[16];
#pragma unroll
        for (int i = 0; i < 16; ++i) s[i] = 0.f;
#pragma unroll
        for (int k = 0; k < 8; ++k) { const u32x4 w = *(const u32x4*)(y8 + ((size_t)tok * 8 + k) * DM + 16 * lane);
#pragma unroll
            for (int q = 0; q < 4; ++q) { const f32x2 lo = __builtin_amdgcn_cvt_pk_f32_fp8((int)w[q], false), hi = __builtin_amdgcn_cvt_pk_f32_fp8((int)w[q], true);
                s[4 * q] += lo[0]; s[4 * q + 1] += lo[1]; s[4 * q + 2] += hi[0]; s[4 * q + 3] += hi[1]; } }
#pragma unroll
        for (int q = 0; q < 4; ++q) { f32x4 v; v[0] = a[4 * q] + 0.125f * s[4 * q]; v[1] = a[4 * q + 1] + 0.125f * s[4 * q + 1]; v[2] = a[4 * q + 2] + 0.125f * s[4 * q + 2]; v[3] = a[4 * q + 3] + 0.125f * s[4 * q + 3]; *(f32x4*)(op + 4 * q) = v; }
    }
}

__global__ void __launch_bounds__(512, 2) mk_fwd(Args args) {
    extern __shared__ __attribute__((aligned(16))) unsigned char lds_raw[];
    Ctx C;
    C.lds_generic = lds_raw; C.lds = (LAS unsigned char*)lds_raw;
    C.tid = threadIdx.x; C.lane = C.tid & 63; C.wid = __builtin_amdgcn_readfirstlane(C.tid >> 6);
    C.G = gridDim.x; { const int bx = blockIdx.x; C.vcu = (C.G % 8 == 0) ? (bx % 8) * (C.G / 8) + bx / 8 : bx; }
    C.out = args.out; C.ws = args.ws;
    for (int u = C.tid; u < (LDS_BYTES - LDSCTL_OFF) / 4; u += 512) ((LAS unsigned*)(C.lds + LDSCTL_OFF))[u] = 0u;
    __syncthreads();
    const int lo = args.ph_lo, hi = args.ph_hi;
    unsigned* ctl = (unsigned*)(C.ws + WS_CTL);
    XcdBarrier bar; bar.bar = ctl + CW_BAR; bar.x = 0; bar.st = nullptr;
    if (hi - lo > 1) bar = xcd_barrier_post(ctl + CW_BAR, (volatile LAS unsigned*)(C.lds + MISC_OFF) + 8);
#ifndef MK_PHASE_MASK
#define MK_PHASE_MASK 0x1ff
#endif
#define IN(k) (((MK_PHASE_MASK >> (k)) & 1) && lo <= (k) && (k) < hi)
#define SEAM(k) do { if (IN(k) && IN((k) + 1)) xcd_barrier(bar); } while (0)
    LAS int* toff = (LAS int*)(C.lds + TOFF_OFF); LAS int* lcnt = (LAS int*)(C.lds + LCNT_OFF); LAS unsigned* tab = (LAS unsigned*)(C.lds + TAB_OFF);

    if (IN(0)) { p0_prologue(C); SEAM(0); }
    if (IN(1)) {
        { pg8::SchedStatic S; S.init(T_TOK, DIN, DM, C.G, (int)blockIdx.x, C.ws + WS_W1T);
          pg8::EpiRowScaleBf16 E{(bf16_t*)(C.ws + WS_PROJ), DIN, (const float*)(C.ws + WS_RINV1)};
          pg8::gemm_phase(C.lds, tab, (const char*)(C.ws + WS_XB), DM, S, E); }
        { pg8::SchedStatic S; S.init(NMEM, 512, DM, C.G, (int)blockIdx.x, C.ws + WS_WMT);
          pg8::EpiRowScaleBf16 E{(bf16_t*)(C.ws + WS_KVM), 512, nullptr};
          pg8::gemm_phase(C.lds, tab, (const char*)(C.ws + WS_MEMN), DM, S, E); }
        SEAM(1);
    }
    if (IN(2)) { p2_mixers(C); SEAM(2); }
    if (IN(3)) { p3_norm(C); SEAM(3); }
    if (IN(4)) {
        pg8::SchedStatic S; S.init(T_TOK, DM, DM, C.G, (int)blockIdx.x, C.ws + WS_W2T);
        pg8::EpiX1 E{in_ptr(0), C.out, (bf16_t*)(C.ws + WS_X1B)};
        pg8::gemm_phase(C.lds, tab, (const char*)(C.ws + WS_O), DM, S, E);
        SEAM(4);
    }
    if (IN(5)) { p5_router(C); SEAM(5); }
    if (IN(6)) {
        moe_prep(C, toff, lcnt);
        pg8::SchedGU S{toff, lcnt, 2 * __builtin_amdgcn_readfirstlane(toff[65]), C.G, C.vcu, (const int*)(C.ws + WS_EXPL), (const char*)(C.ws + WS_WGU)};
        pg8::EpiGU E{(const int*)(C.ws + WS_EXPL), (const float*)(C.ws + WS_RINV2), (bf16_t*)(C.ws + WS_HID)};
        pg8::gemm_phase(C.lds, tab, (const char*)(C.ws + WS_X1B), DM, S, E);
        SEAM(6);
    }
    if (IN(7)) {
        moe_prep(C, toff, lcnt);
        { pg8::SchedDown S{toff, lcnt, 0, __builtin_amdgcn_readfirstlane(toff[64]), C.G, C.vcu, (const char*)(C.ws + WS_WD)};
          pg8::EpiDownR E{(const int*)(C.ws + WS_EXPL), (const float*)(C.ws + WS_GATEW), C.ws + WS_Y8};
          pg8::gemm_phase(C.lds, tab, (const char*)(C.ws + WS_HID), DEXP, S, E); }
        { pg8::SchedDown S{toff, lcnt, __builtin_amdgcn_readfirstlane(toff[64]), __builtin_amdgcn_readfirstlane(toff[65]), C.G, C.vcu, (const char*)(C.ws + WS_WD)};
          pg8::EpiDownS E{C.out};
          pg8::gemm_phase(C.lds, tab, (const char*)(C.ws + WS_HID), DEXP, S, E); }
        SEAM(7);
    }
    if (IN(8)) { p8_combine(C); }
#undef IN
#undef SEAM
}

extern "C" void kernel_launch(void* const* d_in, const int* in_sizes, int n_in, void* d_out, int out_size, void* d_ws, size_t ws_size, hipStream_t stream) {
    static int grid = 0;
    if (grid == 0) {
        if (n_in != 28 || out_size != T_TOK * DM || ws_size < WS_END) { fprintf(stderr, "kernel_launch: unexpected shapes (n_in %d out %d ws %zu)\n", n_in, out_size, ws_size); grid = -1; return; }
        int dev = 0, cus = 0, per_cu = 0;
        if (hipGetDevice(&dev) != hipSuccess || hipDeviceGetAttribute(&cus, hipDeviceAttributeMultiprocessorCount, dev) != hipSuccess) { grid = -1; return; }
        if (hipFuncSetAttribute((const void*)mk_fwd, hipFuncAttributeMaxDynamicSharedMemorySize, LDS_BYTES) != hipSuccess) { fprintf(stderr, "kernel_launch: hipFuncSetAttribute failed\n"); grid = -1; return; }
        if (hipOccupancyMaxActiveBlocksPerMultiprocessor(&per_cu, (const void*)mk_fwd, 512, LDS_BYTES) != hipSuccess || per_cu < 1) fprintf(stderr, "kernel_launch: occupancy query says %d\n", per_cu);
        (void)hipGetLastError();
        grid = cus;
    }
    if (grid < 0) return;
    (void)hipMemsetAsync((char*)d_ws + WS_CTL, 0, CTL_ZERO_BYTES, stream);
    Args a{};
    for (int i = 0; i < 28; ++i) a.in[i] = (const float*)d_in[i];
    a.out = (float*)d_out; a.ws = (unsigned char*)d_ws;
    if (MK_N_LAUNCHES == 1) { a.ph_lo = 0; a.ph_hi = NPHASE; hipLaunchKernelGGL(mk_fwd, dim3(grid), dim3(512), LDS_BYTES, stream, a); }
    else { for (int p = 0; p < NPHASE; ++p) { a.ph_lo = p; a.ph_hi = p + 1; hipLaunchKernelGGL(mk_fwd, dim3(grid), dim3(512), LDS_BYTES, stream, a); } }
}
```

```cpp
#include <hip/hip_runtime.h>
#include <cstdio>
#include <cstdint>

#ifndef MK_N_LAUNCHES
#define MK_N_LAUNCHES 1
#endif

#ifndef MK_REPEAT
#define MK_REPEAT -1
#endif
#ifndef MK_REPEAT_N
#define MK_REPEAT_N 1
#endif
#define DI __device__ __forceinline__
#define LAS __attribute__((address_space(3)))
#define GAS __attribute__((address_space(1)))
typedef unsigned short bf16_t;
typedef short bf16x8 __attribute__((ext_vector_type(8)));
typedef float f32x4 __attribute__((ext_vector_type(4)));
typedef float f32x2 __attribute__((ext_vector_type(2)));
typedef float f32x16 __attribute__((ext_vector_type(16)));
typedef unsigned u32x4 __attribute__((ext_vector_type(4)));
typedef unsigned u32x2 __attribute__((ext_vector_type(2)));
typedef __bf16 bf16x2_t __attribute__((ext_vector_type(2)));
typedef GAS unsigned gu32;
#define RLX_AGENT __ATOMIC_RELAXED, __HIP_MEMORY_SCOPE_AGENT

constexpr int T_TOK = 65536, DM = 1024, DIN = 2304, SEQ = 4096, NBATCH = 16, MEMLEN = 256, NMEM = NBATCH * MEMLEN;
constexpr int NEXP = 64, TOPK = 8, DEXP = 256, CAP = 65536;
constexpr float RMS_EPS = 1e-6f;
constexpr int COL_Q = 0, COL_K = 512, COL_V = 1024, COL_XRG = 1536, COL_GRG = 1792, COL_QCA = 2048;
constexpr int NPHASE = 9;

constexpr size_t MiB = 1u << 20;
constexpr size_t WS_CTL = 0, CTL_ZERO_BYTES = 1 * MiB;
constexpr size_t WS_RINV1 = 1 * MiB, WS_SEG = 2 * MiB, WS_WRHI = 3 * MiB, WS_WRLO = 3 * MiB + 128 * 1024, WS_RGW = 3 * MiB + 256 * 1024;
constexpr size_t WS_W1T = 8 * MiB, WS_W2T = 13 * MiB, WS_WMT = 15 * MiB, WS_WGU = 16 * MiB, WS_WD = 81 * MiB;
constexpr size_t WS_MEMN = 114 * MiB, WS_KVM = 122 * MiB;
constexpr size_t WS_PROJ = 144 * MiB, WS_HID = 144 * MiB;
constexpr size_t WS_XB = 440 * MiB, WS_X1B = 440 * MiB, WS_O = 568 * MiB, WS_Y8 = 440 * MiB, WS_Y8S = WS_WGU  ;
constexpr size_t WS_AOFF = 952 * MiB, WS_PRINV = 969 * MiB, WS_PPAIR = 986 * MiB, WS_PGW = 1003 * MiB, WS_END = 1020 * MiB;
constexpr int CW_TMO = 0, CW_BAR = 4096, CW_CNT = 16384;

constexpr int RING_BYTES = 131072, LDSCTL_OFF = RING_BYTES, MISC_OFF = LDSCTL_OFF + 320, TOFF_OFF = LDSCTL_OFF + 1024, LCNT_OFF = TOFF_OFF + 512, TAB_OFF = LDSCTL_OFF + 2048  , UDESC_OFF = LDSCTL_OFF + 12288  ;
constexpr int LDS_BYTES = 147456;

DI unsigned pk2(float lo, float hi) { f32x2 v = {lo, hi}; return __builtin_bit_cast(unsigned, __builtin_convertvector(v, bf16x2_t)); }
DI float bf2f(unsigned short b) { return __uint_as_float((unsigned)b << 16); }
DI bf16_t f2bf(float f) { return (bf16_t)(pk2(f, 0.f) & 0xffffu); }
DI float bflo(unsigned w) { return __uint_as_float(w << 16); }
DI float bfhi(unsigned w) { return __uint_as_float(w & 0xffff0000u); }
DI float wave_sum(float v) {
#pragma unroll
    for (int o = 1; o < 64; o <<= 1) v += __shfl_xor(v, o);
    return v;
}
DI int crow(int r, int h) { return (r & 3) + 8 * (r >> 2) + 4 * h; }
DI float sigmoidf_(float v) { return 1.f / (1.f + __expf(-v)); }
#define MFMA32(a, b, c) __builtin_amdgcn_mfma_f32_32x32x16_bf16((a), (b), (c), 0, 0, 0)
#define MFMA16(a, b, c) __builtin_amdgcn_mfma_f32_16x16x32_bf16((a), (b), (c), 0, 0, 0)
#define LDS_WAIT() asm volatile("s_waitcnt lgkmcnt(0)" ::: "memory")
#define VM_WAIT() asm volatile("s_waitcnt vmcnt(0)" ::: "memory")

#define XB_TMO      128
#define XB_XCNT(j)  (256  + 64 * (j))
#define XB_XSUB(j)  (1280 + 64 * (j))
#define XB_XGEN(j)  (2304 + 64 * (j))
#define XB_TOP      3328
#define XB_TOPGEN   3392
#define XCD_BAR_WORDS 3456
#define XB_SPIN_CAP (1u << 18)
DI unsigned xb_ld(unsigned* p)              { return __hip_atomic_load(p, __ATOMIC_RELAXED, __HIP_MEMORY_SCOPE_AGENT); }
DI unsigned xb_add(unsigned* p, unsigned v) { return __hip_atomic_fetch_add(p, v, __ATOMIC_RELAXED, __HIP_MEMORY_SCOPE_AGENT); }
DI unsigned xb_xcc_id() { return (unsigned)__builtin_amdgcn_s_getreg((3 << 11) | 20) & 0xFu; }
#define XB_SPIN(cond, bar) do { unsigned _sp = 0; while (cond) { __builtin_amdgcn_s_sleep(1); \
    if ((++_sp & 255u) == 0u) { if (xb_ld(&(bar)[XB_TMO])) break; if (_sp > XB_SPIN_CAP) { atomicAdd(&(bar)[XB_TMO], 1u); break; } } } } while (0)
struct XcdBarrier { unsigned* bar; unsigned x; volatile LAS unsigned* st; };
DI XcdBarrier xcd_barrier_post(unsigned* bar, volatile LAS unsigned* st) {
    XcdBarrier b; b.bar = bar; b.x = xb_xcc_id(); b.st = st;
    if (threadIdx.x == 0) (void)xb_add(&bar[XB_XCNT(b.x)], 1u);
    return b;
}
DI void xcd_barrier_complete(unsigned* bar, unsigned x, unsigned& nloc, unsigned& nx) {
    const unsigned G = gridDim.x * gridDim.y * gridDim.z;
    unsigned sum, cnt, mine, sp = 0u;
    for (;;) {
        sum = 0u; cnt = 0u; mine = 0u;
#pragma unroll
        for (unsigned j = 0; j < 16; ++j) { const unsigned c = xb_ld(&bar[XB_XCNT(j)]); sum += c; cnt += (c > 0u) ? 1u : 0u; mine = (j == x) ? c : mine; }
        if (sum == G) break;
        __builtin_amdgcn_s_sleep(1);
        if ((++sp & 255u) == 0u) { if (xb_ld(&bar[XB_TMO])) break; if (sp > XB_SPIN_CAP) { atomicAdd(&bar[XB_TMO], 1u); break; } }
    }
    nloc = mine > 0u ? mine : 1u; nx = cnt > 0u ? cnt : 1u;
}
DI void xcd_barrier(const XcdBarrier& b) {
    asm volatile("s_waitcnt vmcnt(0)" ::: "memory");
    __syncthreads();
    if (threadIdx.x == 0) {
        unsigned* bar = b.bar;
        __builtin_amdgcn_s_waitcnt(0);
        unsigned nloc = b.st[0], nx = b.st[1];
        if (nloc == 0u) { xcd_barrier_complete(bar, b.x, nloc, nx); b.st[0] = nloc; b.st[1] = nx; }
        const unsigned old = xb_add(&bar[XB_XSUB(b.x)], 1u);
        const unsigned gen = old / nloc;
        if (old + 1u == (gen + 1u) * nloc) {
            __builtin_amdgcn_fence(__ATOMIC_RELEASE, "agent");
            asm volatile("s_waitcnt vmcnt(0)" ::: "memory");
            const unsigned og = xb_add(&bar[XB_TOP], 1u);
            const unsigned tg = og / nx;
            if (og + 1u == (tg + 1u) * nx) xb_add(&bar[XB_TOPGEN], 1u);
            else XB_SPIN(xb_ld(&bar[XB_TOPGEN]) == tg, bar);
            __builtin_amdgcn_fence(__ATOMIC_ACQUIRE, "agent");
            xb_add(&bar[XB_XGEN(b.x)], 1u);
            asm volatile("s_waitcnt vmcnt(0)" ::: "memory");
        } else {
            XB_SPIN(xb_ld(&bar[XB_XGEN(b.x)]) == gen, bar);
            __builtin_amdgcn_fence(__ATOMIC_ACQUIRE, "agent");
            asm volatile("s_waitcnt vmcnt(0)" ::: "memory");
        }
    }
    __syncthreads();
}

namespace pg8 {
constexpr int BM = 256, BK = 64, HALF = 128, HTB = HALF * BK * 2, STAGE_BYTES = 8 * HTB, NXCD = 8, WGM = 8;
__host__ __device__ __forceinline__ int lds_byte(int r, int c) { const int st = (r >> 4) * 2 + (c >> 5), rr = r & 15, cc = c & 31, ob = rr * 64 + cc * 2; return st * 1024 + (ob ^ (((ob >> 9) & 1) << 5)); }
__host__ __device__ __forceinline__ void stage_rc(int b, int& R, int& C) { const int st = b / 1024, sb = b % 1024, swz = sb ^ (((sb >> 9) & 1) << 5); R = (st >> 1) * 16 + swz / 64; C = (st & 1) * 32 + (swz % 64) / 2; }
__host__ __device__ __forceinline__ int perm32(int rho) { const int n = rho >> 4, i = rho & 15; return 8 * (i >> 2) + 4 * n + (i & 3); }

template <class Epi, class Sched>
DI void gemm_phase(LAS unsigned char* lds, LAS unsigned* tab  , const char* Abase, const int K, const Sched& S, const Epi& E) {
    typedef typename Sched::Unit Unit;
    const int tid = threadIdx.x, wid = __builtin_amdgcn_readfirstlane(tid >> 6), lane = tid & 63, wr = wid >> 2, wc = wid & 3, fr = lane & 15, fq = lane >> 4;
    const int nt = K / BK;
    int Rr[2]; unsigned Cc[2], voffB[2];
#pragma unroll
    for (int i = 0; i < 2; ++i) { int R, C; stage_rc(tid * 16 + i * 8192, R, C); const int Rb = Epi::PERM ? ((R & ~31) + perm32(R & 31)) : R;
        Rr[i] = R; Cc[i] = (unsigned)C * 2u; voffB[i] = (unsigned)(Rb * K + C) * 2u; }
    const size_t kstep = (size_t)(BK * 2);
    const size_t hstepB = (size_t)HALF * K * 2;
    const unsigned ldsw = (unsigned)wid * 1024u;
    const int aoff = lds_byte(wr * 64 + fr, fq * 8), boff = lds_byte(wc * 32 + fr, fq * 8);
#define PG8_SA(b, h) (((b) * 2 + (h)) * HTB)
#define PG8_SB(b, h) ((4 + (b) * 2 + (h)) * HTB)
#define PG8_STAGE_B(bufoff, gbase) do { _Pragma("unroll") for (int _i = 0; _i < 2; ++_i) \
        __builtin_amdgcn_global_load_lds((const unsigned*)((const char*)(gbase) + voffB[_i]), (LAS unsigned*)(lds + (bufoff) + ldsw + _i * 8192), 16, 0, 0); } while (0)
#define PG8_STAGE_A(bufoff, slot, h, kb) do { _Pragma("unroll") for (int _i = 0; _i < 2; ++_i) \
        __builtin_amdgcn_global_load_lds((const unsigned*)(Abase + (size_t)(tab[(slot) * 768 + (h) * HALF + Rr[_i]] + Cc[_i]) + (size_t)(kb)), (LAS unsigned*)(lds + (bufoff) + ldsw + _i * 8192), 16, 0, 0); } while (0)
#define PG8_FILL(slot, unit) S.fill(tab + (slot) * 768, unit, tid, wid)
#define PG8_LDA(dst, b, h) do { _Pragma("unroll") for (int m = 0; m < 4; ++m) _Pragma("unroll") for (int k = 0; k < 2; ++k) dst[m][k] = *(const LAS bf16x8*)(lds + PG8_SA(b, h) + aoff + m * 2048 + k * 1024); } while (0)
#define PG8_LDB(dst, b, h) do { _Pragma("unroll") for (int n = 0; n < 2; ++n) _Pragma("unroll") for (int k = 0; k < 2; ++k) dst[n][k] = *(const LAS bf16x8*)(lds + PG8_SB(b, h) + boff + n * 2048 + k * 1024); } while (0)
#define PG8_MMA(ai, bj, At, Bt) do { __builtin_amdgcn_s_setprio(1); _Pragma("unroll") for (int m = 0; m < 4; ++m) _Pragma("unroll") for (int n = 0; n < 2; ++n) _Pragma("unroll") for (int k = 0; k < 2; ++k) \
        acc[ai][bj][m][n] = __builtin_amdgcn_mfma_f32_16x16x32_bf16(Bt[n][k], At[m][k], acc[ai][bj][m][n], 0, 0, 0); __builtin_amdgcn_s_setprio(0); } while (0)
#define PG8_WAIT_V(n) asm volatile("s_waitcnt vmcnt(" #n ")" ::: "memory")
#define PG8_WAIT_L(n) asm volatile("s_waitcnt lgkmcnt(" #n ")" ::: "memory")
#define PG8_BAR __builtin_amdgcn_s_barrier()
#define PG8_SCHED __builtin_amdgcn_sched_barrier(0)
    Unit cur, nxt; int ui = 0;
    if (!S.next(0, cur)) return;
    f32x4 acc[2][2][4][2];
#pragma unroll
    for (int a = 0; a < 2; ++a)
#pragma unroll
        for (int b = 0; b < 2; ++b)
#pragma unroll
            for (int m = 0; m < 4; ++m)
#pragma unroll
                for (int n = 0; n < 2; ++n) acc[a][b][m][n] = (f32x4){0.f, 0.f, 0.f, 0.f};
    bf16x8 At[4][2], B0[2][2], B1[2][2];
    const char* cB = S.bbase(cur);
    int cs = 0;
    PG8_FILL(0, cur);
    PG8_WAIT_V(0); PG8_WAIT_L(0); PG8_BAR; asm volatile("" ::: "memory");
    PG8_STAGE_B(PG8_SB(0, 0), cB); PG8_STAGE_B(PG8_SB(0, 1), cB + hstepB); PG8_STAGE_A(PG8_SA(0, 0), cs, 0, 0); PG8_STAGE_A(PG8_SA(0, 1), cs, 1, 0);
    if (wr == 1) PG8_BAR;
    PG8_WAIT_V(2); PG8_BAR;
    PG8_STAGE_B(PG8_SB(1, 0), cB + kstep); PG8_STAGE_A(PG8_SA(1, 0), cs, 0, kstep); PG8_STAGE_B(PG8_SB(1, 1), cB + hstepB + kstep);
    PG8_WAIT_V(6); PG8_BAR;
    for (;;) {
        const bool has_next = S.next(ui + 1, nxt);
        const char* nB = has_next ? S.bbase(nxt) : cB;
        const int ns = has_next ? (cs == 2 ? 0 : cs + 1) : cs;
        if (has_next) PG8_FILL(ns, nxt);
        for (int t = 0; t < nt; t += 2) {
            const bool last = (t == nt - 2);
            const size_t k1 = (size_t)(t + 1) * kstep;
            const int v2 = last ? ns : cs;
            const size_t k2 = last ? (size_t)0 : (size_t)(t + 2) * kstep, k3 = k2 + kstep;
            const char* b2 = last ? nB : cB + (size_t)(t + 2) * kstep; const char* b3 = b2 + kstep;
            PG8_LDB(B0, 0, 0); PG8_LDB(B1, 0, 1); PG8_SCHED; PG8_LDA(At, 0, 0); PG8_STAGE_A(PG8_SA(1, 1), cs, 1, k1);
            PG8_WAIT_V(8); PG8_WAIT_L(0); PG8_BAR; PG8_MMA(0, 0, At, B0); PG8_MMA(0, 1, At, B1); PG8_BAR; PG8_SCHED;
            PG8_LDA(At, 0, 1); PG8_STAGE_B(PG8_SB(0, 0), b2); PG8_STAGE_B(PG8_SB(0, 1), b2 + hstepB); PG8_STAGE_A(PG8_SA(0, 0), v2, 0, k2);
            PG8_WAIT_V(8); PG8_WAIT_L(0); PG8_BAR; PG8_MMA(1, 0, At, B0); PG8_MMA(1, 1, At, B1); PG8_BAR; PG8_SCHED;
            PG8_LDB(B0, 1, 0); PG8_LDB(B1, 1, 1); PG8_SCHED; PG8_LDA(At, 1, 0); PG8_STAGE_A(PG8_SA(0, 1), v2, 1, k2);
            PG8_WAIT_V(8); PG8_WAIT_L(0); PG8_BAR; PG8_MMA(0, 0, At, B0); PG8_MMA(0, 1, At, B1); PG8_BAR; PG8_SCHED;
            PG8_LDA(At, 1, 1); PG8_STAGE_B(PG8_SB(1, 0), b3); PG8_STAGE_B(PG8_SB(1, 1), b3 + hstepB); PG8_STAGE_A(PG8_SA(1, 0), v2, 0, k3);
            PG8_WAIT_V(8); PG8_WAIT_L(0); PG8_BAR; PG8_MMA(1, 0, At, B0); PG8_MMA(1, 1, At, B1); PG8_BAR; PG8_SCHED;
        }
        if (wr == 0) PG8_BAR;
        E(acc, cur, tab + cs * 768 + 256, wr, wc, fr, fq);
        if (!has_next) break;
#pragma unroll
        for (int a = 0; a < 2; ++a)
#pragma unroll
            for (int b = 0; b < 2; ++b)
#pragma unroll
                for (int m = 0; m < 4; ++m)
#pragma unroll
                    for (int n = 0; n < 2; ++n) acc[a][b][m][n] = (f32x4){0.f, 0.f, 0.f, 0.f};
        cur = nxt; cB = nB; cs = ns; ++ui;
        if (wr == 1) PG8_BAR;
    }
    PG8_WAIT_V(0);
    PG8_BAR;
#undef PG8_SA
#undef PG8_SB
#undef PG8_STAGE_A
#undef PG8_FILL
#undef PG8_STAGE_B
#undef PG8_LDA
#undef PG8_LDB
#undef PG8_MMA
#undef PG8_WAIT_V
#undef PG8_WAIT_L
#undef PG8_BAR
#undef PG8_SCHED
}

struct SchedStatic {
    struct Unit { int pm, pn; };
    int nM, nN, nwg, G, c, K; const char* Bt;
    DI void init(int M, int N, int K_, int G_, int c_, const void* Bt_) { nM = M / BM; nN = N / BM; nwg = nM * nN; G = G_; c = c_; K = K_; Bt = (const char*)Bt_; }
    DI bool next(int i, Unit& u) const {
        const long L = (long)i * G + c; if (L >= nwg) return false;
        int wgid = (int)L; { const int q = nwg / NXCD, r = nwg % NXCD, xcd = wgid % NXCD, off = wgid / NXCD; wgid = (xcd < r ? xcd * (q + 1) : r * (q + 1) + (xcd - r) * q) + off; }
        const int nig = WGM * nN, gid = wgid / nig, fm = gid * WGM, gsz = (nM - fm) < WGM ? (nM - fm) : WGM;
        u.pm = fm + ((wgid % nig) % gsz); u.pn = (wgid % nig) / gsz; return true;
    }
    DI void fill(LAS unsigned* t, const Unit& u, int tid, int wid) const { if (tid < 256) t[tid] = (unsigned)((u.pm * BM + tid) * K) * 2u; }
    DI const char* bbase(const Unit& u) const { return Bt + (size_t)u.pn * BM * K * 2; }
};
struct MoeUnit { int e, tile, sub, gt, nvalid; };
DI bool moe_desc(const LAS int* desc, int i, MoeUnit& u) {
    if (i >= 64) return false;
    typedef int i32x4 __attribute__((ext_vector_type(4)));
    const i32x4 d = *(const LAS i32x4*)(desc + 4 * i);
    const int rt = __builtin_amdgcn_readfirstlane(d.x); if (rt < 0) return false;
    u.gt = rt; { const int es = __builtin_amdgcn_readfirstlane(d.y); u.e = es & 255; u.sub = es >> 8; } u.tile = __builtin_amdgcn_readfirstlane(d.z); u.nvalid = __builtin_amdgcn_readfirstlane(d.w); return true;
}
DI void dma4(const void* g, LAS unsigned* l) { __builtin_amdgcn_global_load_lds((const unsigned*)g, l, 4, 0, 0); }
struct SchedGU {
    typedef MoeUnit Unit;
    const LAS int* desc; const unsigned* aoff; const unsigned* prinv; const unsigned* zero; const char* W;
    DI bool next(int i, Unit& u) const { return moe_desc(desc, i, u); }
    DI void fill(LAS unsigned* t, const Unit& u, int tid, int wid) const {
        if (wid < 4) { const bool ok = tid < u.nvalid; const size_t idx = (size_t)u.e * CAP + u.tile * 256 + tid;
            dma4(ok ? aoff + idx : zero, t + wid * 64); dma4(ok ? prinv + idx : zero, t + 256 + wid * 64); }
    }
    DI const char* bbase(const Unit& u) const { return W + ((size_t)u.e * 512 + u.sub * 256) * (DM * 2); }
};
struct SchedDown {
    typedef MoeUnit Unit;
    const LAS int* desc; const unsigned* ppair; const unsigned* pgw; const unsigned* zero; const char* W;
    DI bool next(int i, Unit& u) const { return moe_desc(desc, i, u); }
    DI void fill(LAS unsigned* t, const Unit& u, int tid, int wid) const {
        if (wid < 4) { t[tid] = (unsigned)(u.gt * 256 + tid) * (unsigned)(DEXP * 2);
            const bool ok = tid < u.nvalid; const size_t idx = (size_t)u.e * CAP + u.tile * 256 + tid;
            dma4(ok ? ppair + idx : zero, t + 256 + wid * 64); dma4(ok ? pgw + idx : zero, t + 512 + wid * 64); }
    }
    DI const char* bbase(const Unit& u) const { return W + ((size_t)u.e * 1024 + u.sub * 256) * (DEXP * 2); }
};

struct EpiRowScaleBf16 {
    static constexpr bool PERM = true;
    bf16_t* O; int ldc; const float* rs;
    DI void operator()(const f32x4 (&acc)[2][2][4][2], const SchedStatic::Unit& u, const LAS unsigned* meta, int wr, int wc, int fr, int fq) const {
        asm volatile("" : "+v"(fr));
        const int row0 = u.pm * BM + wr * 64 + fr, col0 = u.pn * BM + wc * 32 + 8 * fq;
#pragma unroll
        for (int ai = 0; ai < 2; ++ai)
#pragma unroll
            for (int m = 0; m < 4; ++m) { const int row = row0 + ai * HALF + m * 16; const float sc = rs ? rs[row] : 1.f; bf16_t* rowp = O + (size_t)row * ldc + col0;
#pragma unroll
                for (int bj = 0; bj < 2; ++bj) { const f32x4 v0 = acc[ai][bj][m][0] * sc, v1 = acc[ai][bj][m][1] * sc;
                    u32x4 w; w.x = pk2(v0[0], v0[1]); w.y = pk2(v0[2], v0[3]); w.z = pk2(v1[0], v1[1]); w.w = pk2(v1[2], v1[3]);
                    *(u32x4*)(rowp + bj * HALF) = w; } }
    }
};
struct EpiX1 {
    static constexpr bool PERM = false;
    const float* x; float* out; bf16_t* x1b;
    DI void operator()(const f32x4 (&acc)[2][2][4][2], const SchedStatic::Unit& u, const LAS unsigned* meta, int wr, int wc, int fr, int fq) const {
        asm volatile("" : "+v"(fr));
        const int row0 = u.pm * BM + wr * 64 + fr, col0 = u.pn * BM + wc * 32 + 4 * fq;
#pragma unroll
        for (int ai = 0; ai < 2; ++ai)
#pragma unroll
            for (int m = 0; m < 4; ++m) { const size_t rb = (size_t)(row0 + ai * HALF + m * 16) * DM + col0;
#pragma unroll
                for (int bj = 0; bj < 2; ++bj)
#pragma unroll
                    for (int n = 0; n < 2; ++n) { const size_t off = rb + bj * HALF + n * 16; const f32x4 v = *(const f32x4*)(x + off) + acc[ai][bj][m][n];
                        *(f32x4*)(out + off) = v; u32x2 w; w.x = pk2(v[0], v[1]); w.y = pk2(v[2], v[3]); *(u32x2*)(x1b + off) = w; }
                if (m & 1) asm volatile("" ::: "memory"); }
    }
};
struct EpiGU {
    static constexpr bool PERM = true;
    bf16_t* hid;
    DI void operator()(const f32x4 (&acc)[2][2][4][2], const MoeUnit& u, const LAS unsigned* meta, int wr, int wc, int fr, int fq) const {
        asm volatile("" : "+v"(fr));
#pragma unroll
        for (int ai = 0; ai < 2; ++ai)
#pragma unroll
            for (int m = 0; m < 4; ++m) { const int r = ai * HALF + wr * 64 + m * 16 + fr;
                const float rs = __uint_as_float(meta[r]);
                float hv[8];
#pragma unroll
                for (int n = 0; n < 2; ++n)
#pragma unroll
                    for (int q = 0; q < 4; ++q) { const float g = acc[ai][0][m][n][q] * rs, uu = acc[ai][1][m][n][q] * rs; hv[n * 4 + q] = g * sigmoidf_(g) * uu; }
                u32x4 w; w.x = pk2(hv[0], hv[1]); w.y = pk2(hv[2], hv[3]); w.z = pk2(hv[4], hv[5]); w.w = pk2(hv[6], hv[7]);
                *(u32x4*)(hid + ((size_t)u.gt * 256 + r) * DEXP + u.sub * 128 + wc * 32 + 8 * fq) = w;
                asm volatile("" ::: "memory"); }
    }
};
DI unsigned pk4_fp8(float a, float b, float c, float d) { int w = __builtin_amdgcn_cvt_pk_fp8_f32(a, b, 0, false); w = __builtin_amdgcn_cvt_pk_fp8_f32(c, d, w, true); return (unsigned)w; }
struct EpiDownR {
    static constexpr bool PERM = true;
    unsigned char* y8; unsigned char* y8s;
    DI void operator()(const f32x4 (&acc)[2][2][4][2], const MoeUnit& u, const LAS unsigned* meta, int wr, int wc, int fr, int fq) const {
        asm volatile("" : "+v"(fr));
#pragma unroll
        for (int ai = 0; ai < 2; ++ai)
#pragma unroll
            for (int m = 0; m < 4; ++m) { const int r = ai * HALF + wr * 64 + m * 16 + fr;
                if (r < u.nvalid) { const int p = (int)meta[r]; const float gw = __uint_as_float(meta[256 + r]);
                    unsigned char* rowp = (u.e == NEXP ? y8s : y8) + (size_t)p * DM + u.sub * 256 + wc * 32 + 8 * fq;
#pragma unroll
                    for (int bj = 0; bj < 2; ++bj) { const f32x4 v0 = acc[ai][bj][m][0] * gw, v1 = acc[ai][bj][m][1] * gw;
                        u32x2 w; w.x = pk4_fp8(v0[0], v0[1], v0[2], v0[3]); w.y = pk4_fp8(v1[0], v1[1], v1[2], v1[3]); *(u32x2*)(rowp + bj * HALF) = w; } }
                asm volatile("" ::: "memory"); }
    }
};
}

struct Ctx {
    unsigned char* lds_generic; LAS unsigned char* lds;
    int tid, lane, wid, G, vcu;
    float* out; unsigned char* ws;
};
struct Args { const float* in[28]; float* out; unsigned char* ws; int ph_lo, ph_hi; };

DI const float* in_ptr(int i) {
    const __attribute__((address_space(4))) char* ka = (const __attribute__((address_space(4))) char*)__builtin_amdgcn_kernarg_segment_ptr();
    unsigned off = (unsigned)i * 8u; asm volatile("" : "+s"(off));
    return *(const float* const __attribute__((address_space(4)))*)(ka + off);
}
DI void tr_item(const float* W, int ldn, int k0, int n0, bf16_t* WT, size_t drow0, int ldk, const float* scale, LAS float* scr, int lane) {
#pragma unroll 8
    for (int i = 0; i < 32; ++i) { const int kk = 2 * i + (lane >> 5); const float s = scale ? scale[kk] : 1.f; scr[kk * 33 + (lane & 31)] = W[(size_t)(k0 + kk) * ldn + n0 + (lane & 31)] * s; }
    LDS_WAIT(); asm volatile("" ::: "memory");
    const int c = lane & 7;
#pragma unroll
    for (int j = 0; j < 4; ++j) { const int n = (lane >> 3) + 8 * j; const LAS float* s = scr + (8 * c) * 33 + n;
        u32x4 o; o.x = pk2(s[0 * 33], s[1 * 33]); o.y = pk2(s[2 * 33], s[3 * 33]); o.z = pk2(s[4 * 33], s[5 * 33]); o.w = pk2(s[6 * 33], s[7 * 33]);
        *(u32x4*)(WT + (drow0 + n) * (size_t)ldk + k0 + 8 * c) = o; }
    LDS_WAIT(); asm volatile("" ::: "memory");
}
DI void p0_prologue(const Ctx& C) {
    LAS float* scr = (LAS float*)(C.lds + C.wid * 16384);
    const int gw = C.vcu * 8 + C.wid, NGW = C.G * 8, lane = C.lane;
    bf16_t* W1T = (bf16_t*)(C.ws + WS_W1T); bf16_t* W2T = (bf16_t*)(C.ws + WS_W2T); bf16_t* WMT = (bf16_t*)(C.ws + WS_WMT);
    bf16_t* WGU = (bf16_t*)(C.ws + WS_WGU); bf16_t* WD = (bf16_t*)(C.ws + WS_WD);
    constexpr int I_IN = 16 * 72, I_OUT = 16 * 32, I_MEM = 16 * 16, I_G = 16 * 8, I_D = 4 * 32;
    constexpr int NITEMS = I_IN + I_OUT + I_MEM + 65 * (2 * I_G + I_D);
    for (int it = gw; it < NITEMS; it += NGW) {
        int r = it;
        if (r < I_IN) { const int kb = r / 72, nb = r % 72; tr_item(in_ptr(4), DIN, 64 * kb, 32 * nb, W1T, (size_t)32 * nb, DM, in_ptr(2) + 64 * kb, scr, lane); continue; } r -= I_IN;
        if (r < I_OUT) { const int kb = r / 32, nb = r % 32, k0 = 64 * kb; const float* sc = k0 < 512 ? in_ptr(15) + k0 : (k0 < 768 ? in_ptr(16) + (k0 - 512) : in_ptr(17) + (k0 - 768));
            tr_item(in_ptr(18), DM, k0, 32 * nb, W2T, (size_t)32 * nb, DM, sc, scr, lane); continue; } r -= I_OUT;
        if (r < I_MEM) { const int kb = r / 16, nb = r % 16; tr_item(in_ptr(12), 512, 64 * kb, 32 * nb, WMT, (size_t)32 * nb, DM, in_ptr(3) + 64 * kb, scr, lane); continue; } r -= I_MEM;
        const int e = r / (2 * I_G + I_D); r -= e * (2 * I_G + I_D);
        if (r < 2 * I_G) { const int up = r >= I_G; if (up) r -= I_G; const int kb = r / 8, nb = r % 8, n0 = 32 * nb;
            const float* src = e < NEXP ? (up ? in_ptr(23) : in_ptr(22)) + (size_t)e * DM * DEXP : (up ? in_ptr(26) : in_ptr(25));
            const size_t drow0 = (size_t)e * 512 + (n0 >> 7) * 256 + (up ? 128 : 0) + (n0 & 127);
            tr_item(src, DEXP, 64 * kb, n0, WGU, drow0, DM, in_ptr(19) + 64 * kb, scr, lane); continue; }
        r -= 2 * I_G;
        { const int kb = r / 32, nb = r % 32; const float* src = e < NEXP ? in_ptr(24) + (size_t)e * DEXP * DM : in_ptr(27);
          tr_item(src, DM, 64 * kb, 32 * nb, WD, (size_t)e * 1024 + 32 * nb, DEXP, nullptr, scr, lane); }
    }
    { bf16_t* WRH = (bf16_t*)(C.ws + WS_WRHI); bf16_t* WRL = (bf16_t*)(C.ws + WS_WRLO);
      for (int idx = (C.vcu * 512 + C.tid); idx < DM * NEXP; idx += C.G * 512) { const int k = idx >> 6, n = idx & 63; const float v = in_ptr(20)[idx] * in_ptr(19)[k];
          const bf16_t h = f2bf(v); const bf16_t l = f2bf(v - bf2f(h)); WRH[n * DM + k] = h; WRL[n * DM + k] = l; } }
    { u32x4* RGW = (u32x4*)(C.ws + WS_RGW);
      for (int idx = C.vcu * 512 + C.tid; idx < 2 * 4 * 8 * 64; idx += C.G * 512) { const int ln = idx & 63, f = (idx >> 6) & 7, n = (idx >> 9) & 3, mat = idx >> 11; const int nb = f >> 1, kc = f & 1;
          const float* w = (mat ? in_ptr(9) : in_ptr(7)) + (size_t)n * 4096; const int c0 = 32 * kc + 8 * (ln >> 4), d = 16 * nb + (ln & 15);
          u32x4 o; o.x = pk2(w[(c0 + 0) * 64 + d], w[(c0 + 1) * 64 + d]); o.y = pk2(w[(c0 + 2) * 64 + d], w[(c0 + 3) * 64 + d]); o.z = pk2(w[(c0 + 4) * 64 + d], w[(c0 + 5) * 64 + d]); o.w = pk2(w[(c0 + 6) * 64 + d], w[(c0 + 7) * 64 + d]);
          RGW[idx] = o; } }
    { bf16_t* XB = (bf16_t*)(C.ws + WS_XB); float* R1 = (float*)(C.ws + WS_RINV1); bf16_t* MN = (bf16_t*)(C.ws + WS_MEMN);
      for (int m = gw; m < T_TOK + NMEM; m += NGW) {
          const bool ismem = m >= T_TOK; const float* src = ismem ? in_ptr(1) + (size_t)(m - T_TOK) * DM : in_ptr(0) + (size_t)m * DM;
          const f32x4* xr = (const f32x4*)src + lane; f32x4 v[4]; float s = 0.f;
#pragma unroll
          for (int j = 0; j < 4; ++j) { v[j] = xr[64 * j]; s += (v[j].x * v[j].x + v[j].y * v[j].y) + (v[j].z * v[j].z + v[j].w * v[j].w); }
          const float rinv = 1.0f / sqrtf(wave_sum(s) * (1.f / DM) + RMS_EPS);
          const float mul = ismem ? rinv : 1.f;
          bf16_t* dst = ismem ? MN + (size_t)(m - T_TOK) * DM : XB + (size_t)m * DM;
          u32x2* o8 = (u32x2*)dst + lane;
#pragma unroll
          for (int j = 0; j < 4; ++j) { u32x2 w; w.x = pk2(v[j].x * mul, v[j].y * mul); w.y = pk2(v[j].z * mul, v[j].w * mul); o8[64 * j] = w; }
          if (!ismem && lane == 0) R1[m] = rinv;
      } }
}

DI void stage_v(const bf16_t* gsrc, size_t pitch, LAS bf16_t* vs, int lane) {
    const int row = lane >> 1, c0 = (lane & 1) * 32;
    const u32x4* src = (const u32x4*)(gsrc + (size_t)row * pitch + c0);
    const u32x4 v0 = src[0], v1 = src[1], v2 = src[2], v3 = src[3];
    LAS u32x4* dst = (LAS u32x4*)(vs + row * 72 + c0);
    dst[0] = v0; dst[1] = v1; dst[2] = v2; dst[3] = v3;
}
DI void sb_unit(const bf16_t* proj, bf16_t* obuf, LAS bf16_t* vs, int b, int hd, int qb, int wid, int lane) {
    const int r = lane & 31, h = lane >> 5;
    const int t0 = qb * 256 + wid * 32;
    const size_t rowb = (size_t)b * SEQ;
    bf16x8 qf[4];
    { const bf16_t* qp = proj + (rowb + t0 + r) * DIN + COL_Q + hd * 64 + 8 * h;
#pragma unroll
      for (int c = 0; c < 4; ++c) qf[c] = *(const bf16x8*)(qp + 16 * c); }
    f32x16 o0, o1;
#pragma unroll
    for (int i = 0; i < 16; ++i) { o0[i] = 0.f; o1[i] = 0.f; }
    float R = 0.f;
    const int tq = t0 + r;
    for (int kb = t0 >> 5; kb >= 0; --kb) {
        const int s0 = kb * 32;
        bf16x8 kf[4];
        { const bf16_t* kp = proj + (rowb + s0 + r) * DIN + COL_K + hd * 64 + 8 * h;
#pragma unroll
          for (int c = 0; c < 4; ++c) kf[c] = *(const bf16x8*)(kp + 16 * c); }
        stage_v(proj + (rowb + s0) * DIN + COL_V + hd * 64, DIN, vs, lane);
        f32x16 p;
#pragma unroll
        for (int i = 0; i < 16; ++i) p[i] = 0.f;
#pragma unroll
        for (int c = 0; c < 4; ++c) p = MFMA32(kf[c], qf[c], p);
        float z[16], cs[16], Tg[4], Pg[4], Eg[4];
#pragma unroll
        for (int g = 0; g < 4; ++g) {
            float run = 0.f;
#pragma unroll
            for (int j = 3; j >= 0; --j) { const int i = 4 * g + j; const int kv = s0 + crow(i, h); const bool valid = kv < tq;
                const float zz = p[i] * 0.125f; z[i] = zz;
                const float sp = fmaxf(zz, 0.f) + __logf(1.f + __expf(-fabsf(zz)));
                run += valid ? -sp : 0.f; cs[i] = run; }
            Tg[g] = run;
        }
#pragma unroll
        for (int g = 0; g < 4; ++g) Pg[g] = __shfl_xor(Tg[g], 32);
        float after = 0.f;
#pragma unroll
        for (int g = 3; g >= 0; --g) { Eg[g] = after + (h == 0 ? Pg[g] : 0.f); after += Tg[g] + Pg[g]; }
        float w[16];
#pragma unroll
        for (int i = 0; i < 16; ++i) { const int kv = s0 + crow(i, h); const bool valid = kv < tq; const float lw = z[i] + cs[i] + Eg[i >> 2] + R; w[i] = valid ? __expf(lw) : 0.f; }
        R += after;
#pragma unroll
        for (int s = 0; s < 2; ++s) {
            u32x4 xw; xw.x = pk2(w[8 * s + 0], w[8 * s + 1]); xw.y = pk2(w[8 * s + 2], w[8 * s + 3]); xw.z = pk2(w[8 * s + 4], w[8 * s + 5]); xw.w = pk2(w[8 * s + 6], w[8 * s + 7]);
            const bf16x8 xs = __builtin_bit_cast(bf16x8, xw);
#pragma unroll
            for (int dh = 0; dh < 2; ++dh) {
                bf16x8 pb;
#pragma unroll
                for (int j = 0; j < 8; ++j) pb[j] = (short)vs[(16 * s + 8 * (j >> 2) + 4 * h + (j & 3)) * 72 + 32 * dh + r];
                if (dh == 0) o0 = MFMA32(xs, pb, o0); else o1 = MFMA32(xs, pb, o1);
            }
        }
        if (__all(R < -105.f)) break;
    }
#pragma unroll
    for (int i = 0; i < 16; ++i) { bf16_t* op = obuf + (rowb + t0 + crow(i, h)) * DM + hd * 64 + r; op[0] = f2bf(o0[i]); op[32] = f2bf(o1[i]); }
}
DI void ca_unit(const bf16_t* proj, const bf16_t* kvm, const float* qg, const float* kg, bf16_t* obuf, LAS bf16_t* vs, int b, int hd, int qb, int wid, int lane) {
    const int r = lane & 31, h = lane >> 5;
    const int t0 = qb * 256 + wid * 32;
    const size_t rowb = (size_t)b * SEQ;
    bf16x8 qf[4];
    { const bf16_t* qp = proj + (rowb + t0 + r) * DIN + COL_QCA + hd * 64 + 8 * h;
      float qv[4][8]; float ss = 0.f;
#pragma unroll
      for (int c = 0; c < 4; ++c) { const u32x4 raw = *(const u32x4*)(qp + 16 * c);
#pragma unroll
          for (int q = 0; q < 4; ++q) { qv[c][2 * q] = bflo(raw[q]); qv[c][2 * q + 1] = bfhi(raw[q]); ss += qv[c][2 * q] * qv[c][2 * q] + qv[c][2 * q + 1] * qv[c][2 * q + 1]; } }
      ss += __shfl_xor(ss, 32);
      const float rq = (1.0f / sqrtf(ss * (1.f / 64.f) + RMS_EPS)) * 0.125f;
#pragma unroll
      for (int c = 0; c < 4; ++c) { const float* g = qg + 16 * c + 8 * h; u32x4 w;
#pragma unroll
          for (int q = 0; q < 4; ++q) w[q] = pk2(qv[c][2 * q] * rq * g[2 * q], qv[c][2 * q + 1] * rq * g[2 * q + 1]);
          qf[c] = __builtin_bit_cast(bf16x8, w); } }
#define CA_QK(kb, accv) do { const bf16_t* kp = kvm + ((size_t)b * MEMLEN + (kb) * 32 + r) * 512 + hd * 64 + 8 * h; \
        u32x4 raw[4]; float ss_ = 0.f; \
        _Pragma("unroll") for (int c = 0; c < 4; ++c) { raw[c] = *(const u32x4*)(kp + 16 * c); \
            _Pragma("unroll") for (int q = 0; q < 4; ++q) { const float a_ = bflo(raw[c][q]), b_ = bfhi(raw[c][q]); ss_ += a_ * a_ + b_ * b_; } } \
        ss_ += __shfl_xor(ss_, 32); \
        const float rk = 1.0f / sqrtf(ss_ * (1.f / 64.f) + RMS_EPS); \
        _Pragma("unroll") for (int i = 0; i < 16; ++i) accv[i] = 0.f; \
        _Pragma("unroll") for (int c = 0; c < 4; ++c) { const float* g = kg + 16 * c + 8 * h; u32x4 w_; \
            _Pragma("unroll") for (int q = 0; q < 4; ++q) w_[q] = pk2(bflo(raw[c][q]) * rk * g[2 * q], bfhi(raw[c][q]) * rk * g[2 * q + 1]); \
            accv = MFMA32(__builtin_bit_cast(bf16x8, w_), qf[c], accv); } } while (0)
    float mx = -3.0e38f;
    for (int kb = 0; kb < 8; ++kb) {
        f32x16 p; CA_QK(kb, p);
#pragma unroll
        for (int i = 0; i < 16; ++i) mx = fmaxf(mx, p[i]);
    }
    mx = fmaxf(mx, __shfl_xor(mx, 32));
    float l = 0.f;
    f32x16 o0, o1;
#pragma unroll
    for (int i = 0; i < 16; ++i) { o0[i] = 0.f; o1[i] = 0.f; }
    for (int kb = 0; kb < 8; ++kb) {
        stage_v(kvm + ((size_t)b * MEMLEN + kb * 32) * 512 + 256 + hd * 64, 512, vs, lane);
        f32x16 p; CA_QK(kb, p);
#pragma unroll
        for (int i = 0; i < 16; ++i) { const float e = __expf(p[i] - mx); p[i] = e; l += e; }
#pragma unroll
        for (int s = 0; s < 2; ++s) {
            u32x4 xw;
#pragma unroll
            for (int q = 0; q < 4; ++q) xw[q] = pk2(p[8 * s + 2 * q], p[8 * s + 2 * q + 1]);
            const bf16x8 xs = __builtin_bit_cast(bf16x8, xw);
#pragma unroll
            for (int dh = 0; dh < 2; ++dh) {
                bf16x8 pb;
#pragma unroll
                for (int j = 0; j < 8; ++j) pb[j] = (short)vs[(16 * s + 8 * (j >> 2) + 4 * h + (j & 3)) * 72 + 32 * dh + r];
                if (dh == 0) o0 = MFMA32(xs, pb, o0); else o1 = MFMA32(xs, pb, o1);
            }
        }
    }
#undef CA_QK
    l += __shfl_xor(l, 32);
    const float inv = 1.f / l;
#pragma unroll
    for (int i = 0; i < 16; ++i) { const float iv = __shfl(inv, crow(i, h)); bf16_t* op = obuf + (rowb + t0 + crow(i, h)) * DM + 768 + hd * 64 + r; op[0] = f2bf(o0[i] * iv); op[32] = f2bf(o1[i] * iv); }
}
DI float neg_expm1(float x) {
    if (x > -0.25f) { return -x * (1.f + x * (0.5f + x * (0.16666667f + x * (0.041666668f + x * (0.0083333338f + x * 0.0013888889f))))); }
    return 1.f - __expf(x);
}
DI float gelu_tanh(float x) { const float y = 0.7978845608f * (x + 0.044715f * x * x * x); const float t = 1.f - 2.f / (__expf(2.f * y) + 1.f); return 0.5f * x * (1.f + t); }
template <bool PASS2>
DI void rg_wave(const Ctx& C, int b, int chunk, LAS unsigned char* wscr, LAS float* ssq) {
    const int lane = C.lane, n = C.wid & 3, half = C.wid >> 2, ch = 64 * n + lane;
    const bf16_t* proj = (const bf16_t*)(C.ws + WS_PROJ);
    float* seg = (float*)(C.ws + WS_SEG);
    bf16_t* obuf = (bf16_t*)(C.ws + WS_O);
    const int tl0 = half * 128, t_start = chunk * 256 + tl0, sidx = chunk * 2 + half;
    const size_t rowb = (size_t)b * SEQ;
    const float cw0 = in_ptr(5)[0 * 256 + ch], cw1 = in_ptr(5)[1 * 256 + ch], cw2 = in_ptr(5)[2 * 256 + ch], cw3 = in_ptr(5)[3 * 256 + ch], cb = in_ptr(6)[ch];
    const float brg = in_ptr(8)[ch], big = in_ptr(10)[ch];
    const float lam = in_ptr(11)[ch];
    const float c8 = -8.f * (fmaxf(-lam, 0.f) + __logf(1.f + __expf(-fabsf(lam))));
    bf16x8 wrf[4][2], wif[4][2];
    { const bf16x8* fr_ = (const bf16x8*)(C.ws + WS_RGW) + (size_t)(n * 8) * 64 + lane; const bf16x8* fi_ = fr_ + 4 * 8 * 64;
#pragma unroll
      for (int nb = 0; nb < 4; ++nb)
#pragma unroll
          for (int kc = 0; kc < 2; ++kc) { wrf[nb][kc] = fr_[(nb * 2 + kc) * 64]; wif[nb][kc] = fi_[(nb * 2 + kc) * 64]; } }
    float hst = 0.f, aprod = 1.f;
    if (PASS2) {
        const float* sp = seg + ((size_t)b * 32 * 256 + ch) * 2;
#pragma unroll 4
        for (int s = 0; s < sidx; ++s) { const f32x2 v = *(const f32x2*)(sp + (size_t)s * 512); hst = v.x * hst + v.y; }
    }
    float x3 = 0.f, x2 = 0.f, x1 = 0.f;
    if (t_start > 0) { const bf16_t* xp = proj + (rowb + t_start - 3) * DIN + COL_XRG + ch; x3 = bf2f(xp[0]); x2 = bf2f(xp[DIN]); x1 = bf2f(xp[2 * DIN]); }
    LAS bf16_t* At = (LAS bf16_t*)wscr;
    LAS float* Pr = (LAS float*)(wscr + 2304);
    LAS float* Pi = (LAS float*)(wscr + 2304 + 4096);
    LAS float* Xc = (LAS float*)(wscr + 2304 + 8192);
    for (int sub = 0; sub < 8; ++sub) {
        const int tb = t_start + sub * 16;
#pragma unroll 4
        for (int tt = 0; tt < 16; ++tt) { const float x0 = bf2f(proj[(rowb + tb + tt) * DIN + COL_XRG + ch]);
            const float v = cb + cw0 * x3 + cw1 * x2 + cw2 * x1 + cw3 * x0; Xc[tt * 64 + lane] = v; x3 = x2; x2 = x1; x1 = x0; At[tt * 72 + lane] = f2bf(v); }
        LDS_WAIT(); asm volatile("" ::: "memory");
        bf16x8 af[2];
#pragma unroll
        for (int kc = 0; kc < 2; ++kc) af[kc] = *(const LAS bf16x8*)(At + (lane & 15) * 72 + 32 * kc + 8 * (lane >> 4));
#pragma unroll
        for (int nb = 0; nb < 4; ++nb) { f32x4 ar = {0.f, 0.f, 0.f, 0.f}, ai = {0.f, 0.f, 0.f, 0.f};
#pragma unroll
            for (int kc = 0; kc < 2; ++kc) { ar = MFMA16(af[kc], wrf[nb][kc], ar); ai = MFMA16(af[kc], wif[nb][kc], ai); }
#pragma unroll
            for (int q = 0; q < 4; ++q) { const int t = 4 * (lane >> 4) + q, d = 16 * nb + (lane & 15); Pr[t * 64 + d] = ar[q]; Pi[t * 64 + d] = ai[q]; } }
        LDS_WAIT(); asm volatile("" ::: "memory");
#pragma unroll 2
        for (int tt = 0; tt < 16; ++tt) {
            const float rr = sigmoidf_(Pr[tt * 64 + lane] + brg), ii = sigmoidf_(Pi[tt * 64 + lane] + big);
            const float la = c8 * rr, a = __expf(la), mult = sqrtf(neg_expm1(2.f * la));
            hst = a * hst + mult * ii * Xc[tt * 64 + lane]; aprod *= a;
            if (PASS2) { const size_t row = rowb + tb + tt; const float gate = bf2f(proj[row * DIN + COL_GRG + ch]); const float o = gelu_tanh(gate) * hst;
                obuf[row * DM + 512 + ch] = f2bf(o); const float s2 = wave_sum(o * o); if (lane == 0) ssq[n * 256 + tl0 + sub * 16 + tt] = s2; }
        }
        LDS_WAIT(); asm volatile("" ::: "memory");
    }
    if (!PASS2) { *(f32x2*)(seg + (((size_t)b * 32 + sidx) * 256 + ch) * 2) = (f32x2){aprod, hst}; }
}
DI void p2_mixers(const Ctx& C) {
    const bf16_t* proj = (const bf16_t*)(C.ws + WS_PROJ); const bf16_t* kvm = (const bf16_t*)(C.ws + WS_KVM); bf16_t* obuf = (bf16_t*)(C.ws + WS_O);
    constexpr int N_RG = 256, N_CA = NBATCH * 4 * 16, N_SB = NBATCH * 8 * 16;
    for (int L = C.vcu; L < N_RG + N_CA + N_SB; L += C.G) {
        if (L < N_RG) { rg_wave<false>(C, L >> 4, L & 15, C.lds + C.wid * 15360, nullptr); }
        else if (L < N_RG + N_CA) { const int u = L - N_RG; const int qb = u & 15, hd = (u >> 4) & 3, b = u >> 6; ca_unit(proj, kvm, in_ptr(13), in_ptr(14), obuf, (LAS bf16_t*)(C.lds + C.wid * 15360), b, hd, qb, C.wid, C.lane); }
        else { const int u = L - N_RG - N_CA; const int qb = u & 15, hd = (u >> 4) & 7, b = u >> 7; sb_unit(proj, obuf, (LAS bf16_t*)(C.lds + C.wid * 15360), b, hd, qb, C.wid, C.lane); }
    }
}
DI void p3_norm(const Ctx& C) {
    bf16_t* obuf = (bf16_t*)(C.ws + WS_O);
    LAS float* ssq = (LAS float*)(C.lds + 122880);
    for (int L = C.vcu; L < 256; L += C.G) {
        const int b = L >> 4, chunk = L & 15;
        rg_wave<true>(C, b, chunk, C.lds + C.wid * 15360, ssq);
        VM_WAIT(); __syncthreads();
        for (int rr = 0; rr < 32; ++rr) {
            const int tl = C.wid * 32 + rr; const size_t row = (size_t)b * SEQ + chunk * 256 + tl; bf16_t* rp = obuf + row * DM; const int lane = C.lane;
            const u32x4 sb = *(const u32x4*)(rp + 8 * lane); const u32x2 rg = *(const u32x2*)(rp + 512 + 4 * lane); const u32x2 ca = *(const u32x2*)(rp + 768 + 4 * lane);
            float vs[8], vr[4], vc[4]; float s_sb = 0.f, s_ca = 0.f;
#pragma unroll
            for (int q = 0; q < 4; ++q) { vs[2 * q] = bflo(sb[q]); vs[2 * q + 1] = bfhi(sb[q]); s_sb += vs[2 * q] * vs[2 * q] + vs[2 * q + 1] * vs[2 * q + 1]; }
#pragma unroll
            for (int q = 0; q < 2; ++q) { vr[2 * q] = bflo(rg[q]); vr[2 * q + 1] = bfhi(rg[q]); vc[2 * q] = bflo(ca[q]); vc[2 * q + 1] = bfhi(ca[q]); s_ca += vc[2 * q] * vc[2 * q] + vc[2 * q + 1] * vc[2 * q + 1]; }
            s_sb = wave_sum(s_sb); s_ca = wave_sum(s_ca);
            const float s_rg = (ssq[tl] + ssq[256 + tl]) + (ssq[512 + tl] + ssq[768 + tl]);
            const float i_sb = 1.0f / sqrtf(s_sb * (1.f / 512.f) + RMS_EPS), i_rg = 1.0f / sqrtf(s_rg * (1.f / 256.f) + RMS_EPS), i_ca = 1.0f / sqrtf(s_ca * (1.f / 256.f) + RMS_EPS);
            u32x4 w; w.x = pk2(vs[0] * i_sb, vs[1] * i_sb); w.y = pk2(vs[2] * i_sb, vs[3] * i_sb); w.z = pk2(vs[4] * i_sb, vs[5] * i_sb); w.w = pk2(vs[6] * i_sb, vs[7] * i_sb);
            *(u32x4*)(rp + 8 * lane) = w;
            u32x2 w2; w2.x = pk2(vr[0] * i_rg, vr[1] * i_rg); w2.y = pk2(vr[2] * i_rg, vr[3] * i_rg); *(u32x2*)(rp + 512 + 4 * lane) = w2;
            u32x2 w3; w3.x = pk2(vc[0] * i_ca, vc[1] * i_ca); w3.y = pk2(vc[2] * i_ca, vc[3] * i_ca); *(u32x2*)(rp + 768 + 4 * lane) = w3;
        }
        __syncthreads();
    }
}
DI void p5_router(const Ctx& C) {
    const float* x1 = C.out;
    unsigned* AOFF = (unsigned*)(C.ws + WS_AOFF); float* PRINV = (float*)(C.ws + WS_PRINV); unsigned* PPAIR = (unsigned*)(C.ws + WS_PPAIR); float* PGW = (float*)(C.ws + WS_PGW);
    const bf16_t* WRH = (const bf16_t*)(C.ws + WS_WRHI); const bf16_t* WRL = (const bf16_t*)(C.ws + WS_WRLO);
    unsigned* cnt = (unsigned*)(C.ws + WS_CTL) + CW_CNT;
    LAS float* lg = (LAS float*)C.lds;
    LAS int* sel_e = (LAS int*)(C.lds + 66560);
    LAS float* sel_w = (LAS float*)(C.lds + 66560 + 8192);
    LAS int* sel_r = (LAS int*)(C.lds + 66560 + 16384);
    LAS int* lcount = (LAS int*)(C.lds + 66560 + 24576);
    LAS int* lbase = (LAS int*)(C.lds + 66560 + 24576 + 256);
    LAS float* lbias = (LAS float*)(C.lds + 66560 + 24576 + 512);
    LAS float* lrinv = (LAS float*)(C.lds + 66560 + 24576 + 768);
    const int lane = C.lane, wid = C.wid, tid = C.tid;
    for (int L = C.vcu; L < 256; L += C.G) {
        if (tid < 64) { lcount[tid] = 0; lbias[tid] = in_ptr(21)[tid]; }
        const int tbase = L * 256 + wid * 32;
        f32x4 acc[2][4];
#pragma unroll
        for (int m = 0; m < 2; ++m)
#pragma unroll
            for (int n = 0; n < 4; ++n) acc[m][n] = (f32x4){0.f, 0.f, 0.f, 0.f};
        float ss[2] = {0.f, 0.f};
        const int kq = lane >> 4, l15 = lane & 15;
        for (int k0 = 0; k0 < DM; k0 += 32) {
            bf16x8 ahi[2], alo[2];
#pragma unroll
            for (int m = 0; m < 2; ++m) { const float* p = x1 + (size_t)(tbase + 16 * m + l15) * DM + k0 + 8 * kq; const f32x4 v0 = *(const f32x4*)p, v1 = *(const f32x4*)(p + 4);
                ss[m] += (v0[0] * v0[0] + v0[1] * v0[1]) + (v0[2] * v0[2] + v0[3] * v0[3]) + (v1[0] * v1[0] + v1[1] * v1[1]) + (v1[2] * v1[2] + v1[3] * v1[3]);
                u32x4 hh, ll;
                hh.x = pk2(v0[0], v0[1]); hh.y = pk2(v0[2], v0[3]); hh.z = pk2(v1[0], v1[1]); hh.w = pk2(v1[2], v1[3]);
                ll.x = pk2(v0[0] - bflo(hh.x), v0[1] - bfhi(hh.x)); ll.y = pk2(v0[2] - bflo(hh.y), v0[3] - bfhi(hh.y));
                ll.z = pk2(v1[0] - bflo(hh.z), v1[1] - bfhi(hh.z)); ll.w = pk2(v1[2] - bflo(hh.w), v1[3] - bfhi(hh.w));
                ahi[m] = __builtin_bit_cast(bf16x8, hh); alo[m] = __builtin_bit_cast(bf16x8, ll); }
#pragma unroll
            for (int n = 0; n < 4; ++n) { const size_t wo = (size_t)(16 * n + l15) * DM + k0 + 8 * kq; const bf16x8 bh = *(const bf16x8*)(WRH + wo), bl = *(const bf16x8*)(WRL + wo);
#pragma unroll
                for (int m = 0; m < 2; ++m) { acc[m][n] = MFMA16(bh, ahi[m], acc[m][n]); acc[m][n] = MFMA16(bh, alo[m], acc[m][n]); acc[m][n] = MFMA16(bl, ahi[m], acc[m][n]); } }
        }
#pragma unroll
        for (int m = 0; m < 2; ++m) { float s = ss[m]; s += __shfl_xor(s, 16); s += __shfl_xor(s, 32); const float rinv = 1.0f / sqrtf(s * (1.f / DM) + RMS_EPS);
            const int tl = wid * 32 + 16 * m + l15; if (kq == 0) lrinv[tl] = rinv;
#pragma unroll
            for (int n = 0; n < 4; ++n)
#pragma unroll
                for (int q = 0; q < 4; ++q) lg[tl * 65 + 16 * n + 4 * kq + q] = acc[m][n][q] * rinv; }
        __syncthreads();
        if (tid < 256) {
            LAS float* row = lg + tid * 65;
            for (int e = 0; e < 64; ++e) { const float s = sigmoidf_(row[e]); row[e] = s + lbias[e]; }
            float gs[8];
#pragma unroll
            for (int g = 0; g < 8; ++g) { float m1 = -3.0e38f, m2 = -3.0e38f;
                for (int j = 0; j < 8; ++j) { const float v = row[8 * g + j]; if (v > m1) { m2 = m1; m1 = v; } else if (v > m2) m2 = v; }
                gs[g] = m1 + m2; }
            unsigned gmask = 0u;
#pragma unroll
            for (int it = 0; it < 4; ++it) { float best = -3.0e38f; int bi = 0;
#pragma unroll
                for (int g = 0; g < 8; ++g) { const bool free_ = !((gmask >> g) & 1u); if (free_ && gs[g] > best) { best = gs[g]; bi = g; } }
                gmask |= 1u << bi; }
            unsigned long long chosen = 0ull; float wsum = 0.f;
            for (int k = 0; k < 8; ++k) { float best = -3.0e38f; int be = 0;
                for (int g = 0; g < 8; ++g) { if (!((gmask >> g) & 1u)) continue;
                    for (int j = 0; j < 8; ++j) { const int e = 8 * g + j; if ((chosen >> e) & 1ull) continue; const float v = row[e]; if (v > best) { best = v; be = e; } } }
                chosen |= 1ull << be; const float w = best - lbias[be]; wsum += w; sel_e[tid * 8 + k] = be; sel_w[tid * 8 + k] = w;
                sel_r[tid * 8 + k] = __hip_atomic_fetch_add(lcount + be, 1, __ATOMIC_RELAXED, __HIP_MEMORY_SCOPE_WORKGROUP); }
            const float sc = 2.5f / (wsum + 1e-20f);
            for (int k = 0; k < 8; ++k) sel_w[tid * 8 + k] *= sc;
        }
        __syncthreads();
        if (tid < 64) lbase[tid] = (int)__hip_atomic_fetch_add(cnt + tid, (unsigned)lcount[tid], __ATOMIC_RELAXED, __HIP_MEMORY_SCOPE_AGENT);
        __syncthreads();
        if (tid < 256) { const int tok = L * 256 + tid; const float rv = lrinv[tid];
            for (int k = 0; k < 8; ++k) { const int e = sel_e[tid * 8 + k]; const size_t idx = (size_t)e * CAP + lbase[e] + sel_r[tid * 8 + k];
                AOFF[idx] = (unsigned)tok * (unsigned)(DM * 2); PRINV[idx] = rv; PPAIR[idx] = (unsigned)(tok * 8 + k); PGW[idx] = sel_w[tid * 8 + k] * 8.f; }
            AOFF[(size_t)NEXP * CAP + tok] = (unsigned)tok * (unsigned)(DM * 2); PRINV[(size_t)NEXP * CAP + tok] = rv; PPAIR[(size_t)NEXP * CAP + tok] = (unsigned)tok; PGW[(size_t)NEXP * CAP + tok] = 8.f; }
        __syncthreads();
    }
}
DI void moe_prep(const Ctx& C, LAS int* toff, LAS int* lcnt) {
    unsigned* cnt = (unsigned*)(C.ws + WS_CTL) + CW_CNT;
    __syncthreads();
    if (C.tid < 65) lcnt[C.tid] = C.tid < 64 ? (int)__hip_atomic_load(cnt + C.tid, RLX_AGENT) : T_TOK;
    __syncthreads();
    if (C.tid == 0) { int s = 0; for (int e = 0; e < 65; ++e) { toff[e] = s; s += (lcnt[e] + 255) >> 8; } toff[65] = s; }
    __syncthreads();
}
DI void moe_units(const Ctx& C, const LAS int* toff, const LAS int* lcnt, LAS int* desc, int rt_lo, int rt_hi, int shift) {
    __syncthreads();
    if (C.tid < 64) { const int L = C.tid * C.G + C.vcu; const int rt = rt_lo + (L >> shift), sub = L & ((1 << shift) - 1); int e = 0, tile = 0, nv = 0, r = -1;
        if (rt < rt_hi) { int lo = 0, hi = 64; while (lo < hi) { const int mid = (lo + hi + 1) >> 1; if (toff[mid] <= rt) lo = mid; else hi = mid - 1; }
            e = lo; tile = rt - toff[lo]; const int rem = lcnt[lo] - tile * 256; nv = rem < 256 ? rem : 256; r = rt; }
        desc[4 * C.tid] = r; desc[4 * C.tid + 1] = e | (sub << 8); desc[4 * C.tid + 2] = tile; desc[4 * C.tid + 3] = nv; }
    __syncthreads();
}
DI void p8_combine(const Ctx& C) {
    const unsigned char* y8 = C.ws + WS_Y8; const unsigned char* y8s = C.ws + WS_Y8S; float* out = C.out;
    const int gw = C.vcu * 8 + C.wid, NGW = C.G * 8, lane = C.lane;
    for (int tok = gw; tok < T_TOK; tok += NGW) {
        float a[16];
        float* op = out + (size_t)tok * DM + 16 * lane;
#pragma unroll
        for (int q = 0; q < 4; ++q) { const f32x4 v = *(const f32x4*)(op + 4 * q); a[4 * q] = v[0]; a[4 * q + 1] = v[1]; a[4 * q + 2] = v[2]; a[4 * q + 3] = v[3]; }
        float s[16];
#pragma unroll
        for (int i = 0; i < 16; ++i) s[i] = 0.f;
#pragma unroll
        for (int k = 0; k < 9; ++k) { const u32x4 w = k < 8 ? *(const u32x4*)(y8 + ((size_t)tok * 8 + k) * DM + 16 * lane) : *(const u32x4*)(y8s + (size_t)tok * DM + 16 * lane);
#pragma unroll
            for (int q = 0; q < 4; ++q) { const f32x2 lo = __builtin_amdgcn_cvt_pk_f32_fp8((int)w[q], false), hi = __builtin_amdgcn_cvt_pk_f32_fp8((int)w[q], true);
                s[4 * q] += lo[0]; s[4 * q + 1] += lo[1]; s[4 * q + 2] += hi[0]; s[4 * q + 3] += hi[1]; } }
#pragma unroll
        for (int q = 0; q < 4; ++q) { f32x4 v; v[0] = a[4 * q] + 0.125f * s[4 * q]; v[1] = a[4 * q + 1] + 0.125f * s[4 * q + 1]; v[2] = a[4 * q + 2] + 0.125f * s[4 * q + 2]; v[3] = a[4 * q + 3] + 0.125f * s[4 * q + 3]; *(f32x4*)(op + 4 * q) = v; }
    }
}

__global__ void __launch_bounds__(512, 2) mk_fwd(Args args) {
    extern __shared__ __attribute__((aligned(16))) unsigned char lds_raw[];
    Ctx C;
    C.lds_generic = lds_raw; C.lds = (LAS unsigned char*)lds_raw;
    C.tid = threadIdx.x; C.lane = C.tid & 63; C.wid = __builtin_amdgcn_readfirstlane(C.tid >> 6);
    C.G = gridDim.x; { const int bx = blockIdx.x; C.vcu = (C.G % 8 == 0) ? (bx % 8) * (C.G / 8) + bx / 8 : bx; }
    C.out = args.out; C.ws = args.ws;
    for (int u = C.tid; u < (LDS_BYTES - LDSCTL_OFF) / 4; u += 512) ((LAS unsigned*)(C.lds + LDSCTL_OFF))[u] = 0u;
    __syncthreads();
    const int lo = args.ph_lo, hi = args.ph_hi;
    unsigned* ctl = (unsigned*)(C.ws + WS_CTL);
    XcdBarrier bar; bar.bar = ctl + CW_BAR; bar.x = 0; bar.st = nullptr;
    if (hi - lo > 1) bar = xcd_barrier_post(ctl + CW_BAR, (volatile LAS unsigned*)(C.lds + MISC_OFF) + 8);
#ifndef MK_PHASE_MASK
#define MK_PHASE_MASK 0x1ff
#endif
#define IN(k) (((MK_PHASE_MASK >> (k)) & 1) && lo <= (k) && (k) < hi)
#define SEAM(k) do { if (IN(k) && IN((k) + 1)) xcd_barrier(bar); } while (0)
    LAS int* toff = (LAS int*)(C.lds + TOFF_OFF); LAS int* lcnt = (LAS int*)(C.lds + LCNT_OFF); LAS unsigned* tab = (LAS unsigned*)(C.lds + TAB_OFF); LAS int* udesc = (LAS int*)(C.lds + UDESC_OFF);

    if (IN(0)) { p0_prologue(C); SEAM(0); }
    if (IN(1)) {
        { pg8::SchedStatic S; S.init(T_TOK, DIN, DM, C.G, (int)blockIdx.x, C.ws + WS_W1T);
          pg8::EpiRowScaleBf16 E{(bf16_t*)(C.ws + WS_PROJ), DIN, (const float*)(C.ws + WS_RINV1)};
          pg8::gemm_phase(C.lds, tab, (const char*)(C.ws + WS_XB), DM, S, E); }
        { pg8::SchedStatic S; S.init(NMEM, 512, DM, C.G, (int)blockIdx.x, C.ws + WS_WMT);
          pg8::EpiRowScaleBf16 E{(bf16_t*)(C.ws + WS_KVM), 512, nullptr};
          pg8::gemm_phase(C.lds, tab, (const char*)(C.ws + WS_MEMN), DM, S, E); }
        SEAM(1);
    }
    if (IN(2)) { p2_mixers(C); SEAM(2); }
    if (IN(3)) { p3_norm(C); SEAM(3); }
    if (IN(4)) {
        pg8::SchedStatic S; S.init(T_TOK, DM, DM, C.G, (int)blockIdx.x, C.ws + WS_W2T);
        pg8::EpiX1 E{in_ptr(0), C.out, (bf16_t*)(C.ws + WS_X1B)};
        pg8::gemm_phase(C.lds, tab, (const char*)(C.ws + WS_O), DM, S, E);
        SEAM(4);
    }
    if (IN(5)) { p5_router(C); SEAM(5); }
    if (IN(6)) {
        moe_prep(C, toff, lcnt);
        moe_units(C, toff, lcnt, udesc, 0, __builtin_amdgcn_readfirstlane(toff[65]), 1);
        pg8::SchedGU S{udesc, (const unsigned*)(C.ws + WS_AOFF), (const unsigned*)(C.ws + WS_PRINV), (const unsigned*)(C.ws + WS_CTL) + 1, (const char*)(C.ws + WS_WGU)};
        pg8::EpiGU E{(bf16_t*)(C.ws + WS_HID)};
        pg8::gemm_phase(C.lds, tab, (const char*)(C.ws + WS_X1B), DM, S, E);
        SEAM(6);
    }
    if (IN(7)) {
        moe_prep(C, toff, lcnt);
        moe_units(C, toff, lcnt, udesc, 0, __builtin_amdgcn_readfirstlane(toff[65]), 2);
        pg8::SchedDown S{udesc, (const unsigned*)(C.ws + WS_PPAIR), (const unsigned*)(C.ws + WS_PGW), (const unsigned*)(C.ws + WS_CTL) + 1, (const char*)(C.ws + WS_WD)};
        pg8::EpiDownR E{C.ws + WS_Y8, C.ws + WS_Y8S};
        pg8::gemm_phase(C.lds, tab, (const char*)(C.ws + WS_HID), DEXP, S, E);
        SEAM(7);
    }
    if (IN(8)) { p8_combine(C); }
#undef IN
#undef SEAM
}

extern "C" void kernel_launch(void* const* d_in, const int* in_sizes, int n_in, void* d_out, int out_size, void* d_ws, size_t ws_size, hipStream_t stream) {
    static int grid = 0;
    if (grid == 0) {
        if (n_in != 28 || out_size != T_TOK * DM || ws_size < WS_END) { fprintf(stderr, "kernel_launch: unexpected shapes (n_in %d out %d ws %zu)\n", n_in, out_size, ws_size); grid = -1; return; }
        int dev = 0, cus = 0, per_cu = 0;
        if (hipGetDevice(&dev) != hipSuccess || hipDeviceGetAttribute(&cus, hipDeviceAttributeMultiprocessorCount, dev) != hipSuccess) { grid = -1; return; }
        if (hipFuncSetAttribute((const void*)mk_fwd, hipFuncAttributeMaxDynamicSharedMemorySize, LDS_BYTES) != hipSuccess) { fprintf(stderr, "kernel_launch: hipFuncSetAttribute failed\n"); grid = -1; return; }
        if (hipOccupancyMaxActiveBlocksPerMultiprocessor(&per_cu, (const void*)mk_fwd, 512, LDS_BYTES) != hipSuccess || per_cu < 1) fprintf(stderr, "kernel_launch: occupancy query says %d\n", per_cu);
        (void)hipGetLastError();
        grid = cus;
    }
    if (grid < 0) return;
    (void)hipMemsetAsync((char*)d_ws + WS_CTL, 0, CTL_ZERO_BYTES, stream);
    Args a{};
    for (int i = 0; i < 28; ++i) a.in[i] = (const float*)d_in[i];
    a.out = (float*)d_out; a.ws = (unsigned char*)d_ws;
    if (MK_N_LAUNCHES == 1) { a.ph_lo = 0; a.ph_hi = NPHASE; hipLaunchKernelGGL(mk_fwd, dim3(grid), dim3(512), LDS_BYTES, stream, a); }
    else { for (int p = 0; p < NPHASE; ++p) { a.ph_lo = p; a.ph_hi = p + 1; const int reps = (p == MK_REPEAT) ? 1 + MK_REPEAT_N : 1;
            for (int q = 0; q < reps; ++q) hipLaunchKernelGGL(mk_fwd, dim3(grid), dim3(512), LDS_BYTES, stream, a); } }
}
```

```cpp
#include <hip/hip_runtime.h>
#include <cstdio>
#include <cstdint>

#ifndef MK_N_LAUNCHES
#define MK_N_LAUNCHES 1
#endif

#ifndef STAG_P1
#define STAG_P1 0u
#endif
#ifndef STAG_P4
#define STAG_P4 0u
#endif
#ifndef STAG_P6
#define STAG_P6 0u
#endif
#ifndef STAG_P7
#define STAG_P7 0u
#endif
#ifndef MK_REPEAT
#define MK_REPEAT -1
#endif
#ifndef MK_REPEAT_FLAGS
#define MK_REPEAT_FLAGS 0
#endif
#ifndef MK_REPEAT_N
#define MK_REPEAT_N 1
#endif
#define DI __device__ __forceinline__
#define LAS __attribute__((address_space(3)))
#define GAS __attribute__((address_space(1)))
typedef unsigned short bf16_t;
typedef short bf16x8 __attribute__((ext_vector_type(8)));
typedef float f32x4 __attribute__((ext_vector_type(4)));
typedef float f32x2 __attribute__((ext_vector_type(2)));
typedef float f32x16 __attribute__((ext_vector_type(16)));
typedef unsigned u32x4 __attribute__((ext_vector_type(4)));
typedef unsigned u32x2 __attribute__((ext_vector_type(2)));
typedef __bf16 bf16x2_t __attribute__((ext_vector_type(2)));
typedef GAS unsigned gu32;
#define RLX_AGENT __ATOMIC_RELAXED, __HIP_MEMORY_SCOPE_AGENT

constexpr int T_TOK = 65536, DM = 1024, DIN = 2304, SEQ = 4096, NBATCH = 16, MEMLEN = 256, NMEM = NBATCH * MEMLEN;
constexpr int NEXP = 64, TOPK = 8, DEXP = 256, CAP = 65536;
constexpr float RMS_EPS = 1e-6f;
constexpr int COL_Q = 0, COL_K = 512, COL_V = 1024, COL_XRG = 1536, COL_GRG = 1792, COL_QCA = 2048;
constexpr int NPHASE = 9;

constexpr size_t MiB = 1u << 20;
constexpr size_t WS_CTL = 0, CTL_ZERO_BYTES = 128 * 1024;
constexpr size_t WS_RINV1 = 1 * MiB, WS_SEG = 2 * MiB, WS_WRHI = 3 * MiB, WS_WRLO = 3 * MiB + 128 * 1024, WS_RGW = 3 * MiB + 256 * 1024;
constexpr size_t WS_W1T = 8 * MiB, WS_W2T = 13 * MiB, WS_WMT = 15 * MiB, WS_WGU = 16 * MiB, WS_WD = 81 * MiB;
constexpr size_t WS_MEMN = 114 * MiB, WS_KVM = 122 * MiB;
constexpr size_t WS_PROJ = 144 * MiB, WS_HID = 144 * MiB;
constexpr size_t WS_XB = 440 * MiB, WS_X1Q = 768 * MiB  , WS_O = 568 * MiB, WS_Y8 = 440 * MiB, WS_Y8S = WS_WGU  ;
constexpr size_t WS_HLP = 700 * MiB;
constexpr size_t WS_AOFF = 952 * MiB, WS_PRINV = 969 * MiB, WS_PPAIR = 986 * MiB, WS_PGW = 1003 * MiB, WS_END = 1020 * MiB;
constexpr int CW_TMO = 0, CW_BAR = 4096, CW_CNT = 16384;

constexpr int RING_BYTES = 131072, LDSCTL_OFF = RING_BYTES, MISC_OFF = LDSCTL_OFF + 320, TOFF_OFF = LDSCTL_OFF + 1024, LCNT_OFF = TOFF_OFF + 512, TAB_OFF = LDSCTL_OFF + 2048  , UDESC_OFF = LDSCTL_OFF + 12288  ;
constexpr int LDS_BYTES = 147456;

DI unsigned pk2(float lo, float hi) { f32x2 v = {lo, hi}; return __builtin_bit_cast(unsigned, __builtin_convertvector(v, bf16x2_t)); }
DI float bf2f(unsigned short b) { return __uint_as_float((unsigned)b << 16); }
DI bf16_t f2bf(float f) { return (bf16_t)(pk2(f, 0.f) & 0xffffu); }
DI float bflo(unsigned w) { return __uint_as_float(w << 16); }
DI float bfhi(unsigned w) { return __uint_as_float(w & 0xffff0000u); }
DI float wave_sum(float v) {
#pragma unroll
    for (int o = 1; o < 64; o <<= 1) v += __shfl_xor(v, o);
    return v;
}
DI int crow(int r, int h) { return (r & 3) + 8 * (r >> 2) + 4 * h; }
DI float sigmoidf_(float v) { return __builtin_amdgcn_rcpf(1.f + __builtin_amdgcn_exp2f(v * -1.4426950408889634f)); }
DI unsigned pk4_fp8(float a, float b, float c, float d) { int w = __builtin_amdgcn_cvt_pk_fp8_f32(a, b, 0, false); w = __builtin_amdgcn_cvt_pk_fp8_f32(c, d, w, true); return (unsigned)w; }
#define MFMA32(a, b, c) __builtin_amdgcn_mfma_f32_32x32x16_bf16((a), (b), (c), 0, 0, 0)
#define MFMA16(a, b, c) __builtin_amdgcn_mfma_f32_16x16x32_bf16((a), (b), (c), 0, 0, 0)
#define LDS_WAIT() asm volatile("s_waitcnt lgkmcnt(0)" ::: "memory")
#define VM_WAIT() asm volatile("s_waitcnt vmcnt(0)" ::: "memory")

#define XB_TMO      128
#define XB_XCNT(j)  (256  + 64 * (j))
#define XB_XSUB(j)  (1280 + 64 * (j))
#define XB_XGEN(j)  (2304 + 64 * (j))
#define XB_TOP      3328
#define XB_TOPGEN   3392
#define XCD_BAR_WORDS 3456
#define XB_SPIN_CAP (1u << 18)
DI unsigned xb_ld(unsigned* p)              { return __hip_atomic_load(p, __ATOMIC_RELAXED, __HIP_MEMORY_SCOPE_AGENT); }
DI unsigned xb_add(unsigned* p, unsigned v) { return __hip_atomic_fetch_add(p, v, __ATOMIC_RELAXED, __HIP_MEMORY_SCOPE_AGENT); }
DI unsigned xb_xcc_id() { return (unsigned)__builtin_amdgcn_s_getreg((3 << 11) | 20) & 0xFu; }
#define XB_SPIN(cond, bar) do { unsigned _sp = 0; while (cond) { __builtin_amdgcn_s_sleep(1); \
    if ((++_sp & 255u) == 0u) { if (xb_ld(&(bar)[XB_TMO])) break; if (_sp > XB_SPIN_CAP) { atomicAdd(&(bar)[XB_TMO], 1u); break; } } } } while (0)
struct XcdBarrier { unsigned* bar; unsigned x; volatile LAS unsigned* st; };
DI XcdBarrier xcd_barrier_post(unsigned* bar, volatile LAS unsigned* st) {
    XcdBarrier b; b.bar = bar; b.x = xb_xcc_id(); b.st = st;
    if (threadIdx.x == 0) (void)xb_add(&bar[XB_XCNT(b.x)], 1u);
    return b;
}
DI void xcd_barrier_complete(unsigned* bar, unsigned x, unsigned& nloc, unsigned& nx) {
    const unsigned G = gridDim.x * gridDim.y * gridDim.z;
    unsigned sum, cnt, mine, sp = 0u;
    for (;;) {
        sum = 0u; cnt = 0u; mine = 0u;
#pragma unroll
        for (unsigned j = 0; j < 16; ++j) { const unsigned c = xb_ld(&bar[XB_XCNT(j)]); sum += c; cnt += (c > 0u) ? 1u : 0u; mine = (j == x) ? c : mine; }
        if (sum == G) break;
        __builtin_amdgcn_s_sleep(1);
        if ((++sp & 255u) == 0u) { if (xb_ld(&bar[XB_TMO])) break; if (sp > XB_SPIN_CAP) { atomicAdd(&bar[XB_TMO], 1u); break; } }
    }
    nloc = mine > 0u ? mine : 1u; nx = cnt > 0u ? cnt : 1u;
}
DI void xcd_barrier(const XcdBarrier& b) {
    asm volatile("s_waitcnt vmcnt(0)" ::: "memory");
    __syncthreads();
    if (threadIdx.x == 0) {
        unsigned* bar = b.bar;
        __builtin_amdgcn_s_waitcnt(0);
        unsigned nloc = b.st[0], nx = b.st[1];
        if (nloc == 0u) { xcd_barrier_complete(bar, b.x, nloc, nx); b.st[0] = nloc; b.st[1] = nx; }
        const unsigned old = xb_add(&bar[XB_XSUB(b.x)], 1u);
        const unsigned gen = old / nloc;
        if (old + 1u == (gen + 1u) * nloc) {
            __builtin_amdgcn_fence(__ATOMIC_RELEASE, "agent");
            asm volatile("s_waitcnt vmcnt(0)" ::: "memory");
            const unsigned og = xb_add(&bar[XB_TOP], 1u);
            const unsigned tg = og / nx;
            if (og + 1u == (tg + 1u) * nx) xb_add(&bar[XB_TOPGEN], 1u);
            else XB_SPIN(xb_ld(&bar[XB_TOPGEN]) == tg, bar);
            __builtin_amdgcn_fence(__ATOMIC_ACQUIRE, "agent");
            xb_add(&bar[XB_XGEN(b.x)], 1u);
            asm volatile("s_waitcnt vmcnt(0)" ::: "memory");
        } else {
            XB_SPIN(xb_ld(&bar[XB_XGEN(b.x)]) == gen, bar);
            __builtin_amdgcn_fence(__ATOMIC_ACQUIRE, "agent");
            asm volatile("s_waitcnt vmcnt(0)" ::: "memory");
        }
    }
    __syncthreads();
}

DI void grp_barrier(unsigned* w, unsigned gsize, bool coloc) {
    asm volatile("s_waitcnt vmcnt(0)" ::: "memory");
    __syncthreads();
    if (threadIdx.x == 0) {
        if (!coloc) __builtin_amdgcn_fence(__ATOMIC_RELEASE, "agent");
        asm volatile("s_waitcnt vmcnt(0)" ::: "memory");
        const unsigned old = xb_add(w, 1u), gen = old / gsize;
        if (old + 1u == (gen + 1u) * gsize) (void)xb_add(w + 32, 1u);
        else { unsigned sp = 0u; while (xb_ld(w + 32) == gen) { __builtin_amdgcn_s_sleep(1); if (++sp > (1u << 22)) break; } }
        __builtin_amdgcn_fence(__ATOMIC_ACQUIRE, "agent");
        asm volatile("s_waitcnt vmcnt(0)" ::: "memory");
    }
    __syncthreads();
}

namespace pg8 {
constexpr int BM = 256, BK = 64, HALF = 128, HTB = HALF * BK * 2, STAGE_BYTES = 8 * HTB, NXCD = 8, WGM = 8;
__host__ __device__ __forceinline__ int lds_byte(int r, int c) { const int st = (r >> 4) * 2 + (c >> 5), rr = r & 15, cc = c & 31, ob = rr * 64 + cc * 2; return st * 1024 + (ob ^ (((ob >> 9) & 1) << 5)); }
__host__ __device__ __forceinline__ void stage_rc(int b, int& R, int& C) { const int st = b / 1024, sb = b % 1024, swz = sb ^ (((sb >> 9) & 1) << 5); R = (st >> 1) * 16 + swz / 64; C = (st & 1) * 32 + (swz % 64) / 2; }
__host__ __device__ __forceinline__ int perm32(int rho) { const int n = rho >> 4, i = rho & 15; return 8 * (i >> 2) + 4 * n + (i & 3); }

typedef int i32x8 __attribute__((ext_vector_type(8)));
DI f32x4 zero4() { typedef double f64x2 __attribute__((ext_vector_type(2))); double lo_, hi_; asm volatile("v_mov_b64 %0, 0" : "=v"(lo_)); asm volatile("v_mov_b64 %0, 0" : "=v"(hi_)); const f64x2 v_ = {lo_, hi_}; return __builtin_bit_cast(f32x4, v_); }
template <bool F8> struct Frag;
template <> struct Frag<false> { bf16x8 k[2]; };
template <> struct Frag<true> { i32x8 v; };
template <bool F8, class Epi, class Sched>
DI void gemm_phase(LAS unsigned char* lds, LAS unsigned* tab  , const char* Abase, const int Kb, const Sched& S, const Epi& E, const unsigned stagger_ticks = 0u, const bool skip_epi = false) {
    typedef typename Sched::Unit Unit;
    const int tid = threadIdx.x, wid = __builtin_amdgcn_readfirstlane(tid >> 6), lane = tid & 63, wr = wid >> 2, wc = wid & 3, fr = lane & 15, fq = lane >> 4;
    int nt = Kb / (BK * 2); asm volatile("" : "+s"(nt));
    const unsigned lq = (unsigned)lane >> 2, cb = (((unsigned)lane & 3u) << 4) ^ (((unsigned)lane >> 5) << 5);
    const unsigned lq4 = lq * 4u;
    const unsigned vB = (Epi::PERM ? (16u * (lq >> 2) + (lq & 3u)) : lq) * (unsigned)Kb + cb;
    const unsigned cbw = 64u * ((unsigned)wid & 1u);
#define PG8_SI(i_) (((unsigned)wid + 8u * (i_)) >> 1)
#define PG8_SB_OFF(i_) ((Epi::PERM ? (64u * (PG8_SI(i_) >> 1) + 4u * (PG8_SI(i_) & 1u)) : 16u * PG8_SI(i_)) * (unsigned)Kb + cbw)
    const size_t hdeltaB = (size_t)(Epi::PERM ? 8 : HALF) * Kb;
    const size_t kstep = (size_t)(BK * 2);
    const unsigned ldsw = (unsigned)wid * 1024u;
    int aoff = F8 ? lds_byte(wr * 64 + fr, fq * 16) : lds_byte(wr * 64 + fr, fq * 8), boff = 4 * HTB + (F8 ? lds_byte(wc * 32 + fr, fq * 16) : lds_byte(wc * 32 + fr, fq * 8));
    int aoff2 = aoff, boff2 = boff;
    if constexpr (F8) { const int sw = 16 * (fq & 1); aoff2 = aoff + (16 - sw); aoff += sw; boff2 = boff + (16 - sw); boff += sw; }
    asm volatile("" : "+v"(aoff), "+v"(boff), "+v"(aoff2), "+v"(boff2));
#define PG8_SA(b, h) (((b) * 2 + (h)) * HTB)
#define PG8_SB(b, h) ((4 + (b) * 2 + (h)) * HTB)
#define PG8_STAGE_B(bufoff, h, gbase) do { _Pragma("unroll") for (int _i = 0; _i < 2; ++_i) { unsigned vb_ = vB; asm volatile("" : "+v"(vb_)); \
        __builtin_amdgcn_global_load_lds((const unsigned*)((const char*)(gbase) + (size_t)(h) * hdeltaB + PG8_SB_OFF(_i) + vb_), (LAS unsigned*)(lds + (bufoff) + ldsw + _i * 8192), 16, 0, 0); } } while (0)
#define PG8_STAGE_A(bufoff, slot, h, kb) do { _Pragma("unroll") for (int _i = 0; _i < 2; ++_i) { unsigned lq_ = lq4, cb_ = cb; asm volatile("" : "+v"(lq_), "+v"(cb_)); \
        __builtin_amdgcn_global_load_lds((const unsigned*)(Abase + (size_t)(*(const LAS unsigned*)((const LAS unsigned char*)tab + ((slot) * 768 + (h) * HALF + 16 * PG8_SI(_i)) * 4 + lq_) + cb_) + (size_t)(kb) + cbw), (LAS unsigned*)(lds + (bufoff) + ldsw + _i * 8192), 16, 0, 0); } } while (0)
#define PG8_FILL(slot, unit) S.fill(tab + (slot) * 768, unit, tid, wid)
#define PG8_LD1(dst, off, off2) do { if constexpr (F8) { const u32x4 lo_ = *(const LAS u32x4*)(lds + (off)), hi_ = *(const LAS u32x4*)(lds + (off2)); (dst).v = __builtin_bit_cast(i32x8, __builtin_shufflevector(lo_, hi_, 0, 1, 2, 3, 4, 5, 6, 7)); } \
        else { (dst).k[0] = *(const LAS bf16x8*)(lds + (off)); (dst).k[1] = *(const LAS bf16x8*)(lds + (off) + 1024); } } while (0)
#define PG8_LDA(dst, b, h) do { _Pragma("unroll") for (int m = 0; m < 4; ++m) PG8_LD1(dst[m], aoff + PG8_SA(b, h) + m * 2048, aoff2 + PG8_SA(b, h) + m * 2048); } while (0)
#define PG8_LDB(dst, b, h) do { _Pragma("unroll") for (int n = 0; n < 2; ++n) PG8_LD1(dst[n], boff + ((b) * 2 + (h)) * HTB + n * 2048, boff2 + ((b) * 2 + (h)) * HTB + n * 2048); } while (0)
#define PG8_MMA(ai, bj, At, Bt) do { __builtin_amdgcn_s_setprio(1); \
        if constexpr (F8) { _Pragma("unroll") for (int m = 0; m < 4; ++m) _Pragma("unroll") for (int n = 0; n < 2; ++n) \
            acc[ai][bj][m][n] = __builtin_amdgcn_mfma_scale_f32_16x16x128_f8f6f4(Bt[n].v, At[m].v, acc[ai][bj][m][n], 0, 0, 0, 0x7F7F7F7F, 0, 0x7F7F7F7F); } \
        else { _Pragma("unroll") for (int m = 0; m < 4; ++m) _Pragma("unroll") for (int n = 0; n < 2; ++n) _Pragma("unroll") for (int k = 0; k < 2; ++k) \
            acc[ai][bj][m][n] = __builtin_amdgcn_mfma_f32_16x16x32_bf16(Bt[n].k[k], At[m].k[k], acc[ai][bj][m][n], 0, 0, 0); } \
        __builtin_amdgcn_s_setprio(0); } while (0)
#define PG8_WAIT_V(n) asm volatile("s_waitcnt vmcnt(" #n ")" ::: "memory")
#define PG8_WAIT_L(n) asm volatile("s_waitcnt lgkmcnt(" #n ")" ::: "memory")
#define PG8_BAR __builtin_amdgcn_s_barrier()
#define PG8_SCHED __builtin_amdgcn_sched_barrier(0)
    Unit cur, nxt; int ui = 0;
    if (!S.next(0, cur)) return;
    if (stagger_ticks) { const unsigned long long t0_ = __builtin_amdgcn_s_memrealtime(); while (__builtin_amdgcn_s_memrealtime() - t0_ < stagger_ticks) __builtin_amdgcn_s_sleep(8); }
    f32x4 acc[2][2][4][2];
#pragma unroll
    for (int a = 0; a < 2; ++a)
#pragma unroll
        for (int b = 0; b < 2; ++b)
#pragma unroll
            for (int m = 0; m < 4; ++m)
#pragma unroll
                for (int n = 0; n < 2; ++n) acc[a][b][m][n] = zero4();
    Frag<F8> At[4], B0[2], B1[2];
    const char* cB = S.bbase(cur);
    int cs = 0;
    PG8_FILL(0, cur);
    PG8_WAIT_V(0); PG8_WAIT_L(0); PG8_BAR; asm volatile("" ::: "memory");
    PG8_STAGE_B(PG8_SB(0, 0), 0, cB); PG8_STAGE_B(PG8_SB(0, 1), 1, cB); PG8_STAGE_A(PG8_SA(0, 0), cs, 0, 0); PG8_STAGE_A(PG8_SA(0, 1), cs, 1, 0);
    if (wr == 1) PG8_BAR;
    PG8_WAIT_V(2); PG8_BAR;
    PG8_STAGE_B(PG8_SB(1, 0), 0, cB + kstep); PG8_STAGE_A(PG8_SA(1, 0), cs, 0, kstep); PG8_STAGE_B(PG8_SB(1, 1), 1, cB + kstep);
    PG8_WAIT_V(0); PG8_BAR;
    for (;;) {
        const bool has_next = S.next(ui + 1, nxt);
        const char* nB = has_next ? S.bbase(nxt) : cB;
        const int ns = has_next ? (cs == 2 ? 0 : cs + 1) : cs;
        if (has_next) PG8_FILL(ns, nxt);
#define PG8_TRIP(t, WAITX) do { \
            const bool last = ((t) == nt - 2); \
            const size_t k1 = (size_t)((t) + 1) * kstep; \
            const int v2 = last ? ns : cs; \
            const size_t k2 = last ? (size_t)0 : (size_t)((t) + 2) * kstep, k3 = k2 + kstep; \
            const char* b2 = last ? nB : cB + (size_t)((t) + 2) * kstep; const char* b3 = b2 + kstep; \
              \
            PG8_LDB(B0, 0, 0); PG8_LDB(B1, 0, 1); PG8_SCHED; PG8_LDA(At, 0, 0); PG8_STAGE_A(PG8_SA(1, 1), cs, 1, k1); \
            WAITX; PG8_WAIT_L(0); PG8_BAR; PG8_MMA(0, 0, At, B0); PG8_MMA(0, 1, At, B1); PG8_BAR; PG8_SCHED; \
              \
            PG8_LDA(At, 0, 1); PG8_STAGE_B(PG8_SB(0, 0), 0, b2); PG8_STAGE_B(PG8_SB(0, 1), 1, b2); PG8_STAGE_A(PG8_SA(0, 0), v2, 0, k2); \
            WAITX; PG8_WAIT_L(0); PG8_BAR; PG8_MMA(1, 0, At, B0); PG8_MMA(1, 1, At, B1); PG8_BAR; PG8_SCHED; \
              \
            PG8_LDB(B0, 1, 0); PG8_LDB(B1, 1, 1); PG8_SCHED; PG8_LDA(At, 1, 0); PG8_STAGE_A(PG8_SA(0, 1), v2, 1, k2); \
            PG8_WAIT_V(8); PG8_WAIT_L(0); PG8_BAR; PG8_MMA(0, 0, At, B0); PG8_MMA(0, 1, At, B1); PG8_BAR; PG8_SCHED; \
              \
            PG8_LDA(At, 1, 1); PG8_STAGE_B(PG8_SB(1, 0), 0, b3); PG8_STAGE_B(PG8_SB(1, 1), 1, b3); PG8_STAGE_A(PG8_SA(1, 0), v2, 0, k3); \
            PG8_WAIT_V(8); PG8_WAIT_L(0); PG8_BAR; PG8_MMA(1, 0, At, B0); PG8_MMA(1, 1, At, B1); PG8_BAR; PG8_SCHED; \
        } while (0)
#pragma nounroll
        for (int t = 0; t < nt; t += 2) PG8_TRIP(t, PG8_WAIT_V(8));
#undef PG8_TRIP
        if (wr == 0) PG8_BAR;
        if (!skip_epi) E(acc, cur, tab + cs * 768 + 256, wr, wc, fr, fq);
        if (!has_next) break;
#pragma unroll
        for (int a = 0; a < 2; ++a)
#pragma unroll
            for (int b = 0; b < 2; ++b)
#pragma unroll
                for (int m = 0; m < 4; ++m)
#pragma unroll
                    for (int n = 0; n < 2; ++n) acc[a][b][m][n] = zero4();
        cur = nxt; cB = nB; cs = ns; ++ui;
        if (wr == 1) PG8_BAR;
    }
    PG8_WAIT_V(0);
    PG8_BAR;
#undef PG8_SA
#undef PG8_SB
#undef PG8_STAGE_A
#undef PG8_SI
#undef PG8_SB_OFF
#undef PG8_FILL
#undef PG8_STAGE_B
#undef PG8_LDA
#undef PG8_LDB
#undef PG8_MMA
#undef PG8_LD1
#undef PG8_WAIT_V
#undef PG8_WAIT_L
#undef PG8_BAR
#undef PG8_SCHED
}

struct SchedStatic {
    struct Unit { int pm, pn; };
    int nM, nN, nwg, G, c, K; const char* Bt; const float* rs;
    DI void init(int M, int N, int K_, int G_, int c_, const void* Bt_, const float* rs_) { nM = M / BM; nN = N / BM; nwg = nM * nN; G = G_; c = c_; K = K_; Bt = (const char*)Bt_; rs = rs_; }
    DI bool next(int i, Unit& u) const {
        const long L = (long)i * G + c; if (L >= nwg) return false;
        int wgid = (int)L; { const int q = nwg / NXCD, r = nwg % NXCD, xcd = wgid % NXCD, off = wgid / NXCD; wgid = (xcd < r ? xcd * (q + 1) : r * (q + 1) + (xcd - r) * q) + off; }
        const int nig = WGM * nN, gid = wgid / nig, fm = gid * WGM, gsz = (nM - fm) < WGM ? (nM - fm) : WGM;
        u.pm = fm + ((wgid % nig) % gsz); u.pn = (wgid % nig) / gsz; return true;
    }
    DI void fill(LAS unsigned* t, const Unit& u, int tid, int wid) const { if (wid < 4) { t[tid] = (unsigned)((u.pm * BM + tid) * K) * 2u;     if (rs) __builtin_amdgcn_global_load_lds((const unsigned*)(rs + u.pm * BM + tid), t + 256 + wid * 64, 4, 0, 0); } }
    DI const char* bbase(const Unit& u) const { return Bt + (size_t)u.pn * BM * K * 2; }
};
struct MoeUnit { int e, tile, sub, gt, nvalid; };
DI bool moe_desc(const LAS int* desc, int i, MoeUnit& u) {
    if (i >= 64) return false;
    typedef int i32x4 __attribute__((ext_vector_type(4)));
    const i32x4 d = *(const LAS i32x4*)(desc + 4 * i);
    const int rt = __builtin_amdgcn_readfirstlane(d.x); if (rt < 0) return false;
    u.gt = rt; { const int es = __builtin_amdgcn_readfirstlane(d.y); u.e = es & 255; u.sub = es >> 8; } u.tile = __builtin_amdgcn_readfirstlane(d.z); u.nvalid = __builtin_amdgcn_readfirstlane(d.w); return true;
}
DI void dma4(const void* g, LAS unsigned* l) { __builtin_amdgcn_global_load_lds((const unsigned*)g, l, 4, 0, 0); }
struct SchedGU {
    typedef MoeUnit Unit;
    const LAS int* desc; const unsigned* aoff; const unsigned* prinv; const unsigned* zero; const char* W;
    DI bool next(int i, Unit& u) const { return moe_desc(desc, i, u); }
    DI void fill(LAS unsigned* t, const Unit& u, int tid, int wid) const {
        if (wid < 4) { const bool ok = tid < u.nvalid; const size_t idx = (size_t)u.e * CAP + u.tile * 256 + tid;
            dma4(ok ? aoff + idx : zero, t + wid * 64); dma4(ok ? prinv + idx : zero, t + 256 + wid * 64); }
    }
    DI const char* bbase(const Unit& u) const { return W + ((size_t)u.e * 512 + u.sub * 256) * DM; }
};
struct SchedDown {
    typedef MoeUnit Unit;
    const LAS int* desc; const unsigned* ppair; const unsigned* pgw; const unsigned* zero; const char* W;
    DI bool next(int i, Unit& u) const { return moe_desc(desc, i, u); }
    DI void fill(LAS unsigned* t, const Unit& u, int tid, int wid) const {
        if (wid < 4) { t[tid] = (unsigned)(u.gt * 256 + tid) * (unsigned)DEXP;
            const bool ok = tid < u.nvalid; const size_t idx = (size_t)u.e * CAP + u.tile * 256 + tid;
            dma4(ok ? ppair + idx : zero, t + 256 + wid * 64); dma4(ok ? pgw + idx : zero, t + 512 + wid * 64); }
    }
    DI const char* bbase(const Unit& u) const { return W + ((size_t)u.e * 1024 + u.sub * 256) * DEXP; }
};

struct EpiRowScaleBf16 {
    static constexpr bool PERM = true;
    bf16_t* O; int ldc; bool scaled; float qscale; int qtiles;
    DI void operator()(const f32x4 (&acc)[2][2][4][2], const SchedStatic::Unit& u, const LAS unsigned* meta, int wr, int wc, int fr, int fq) const {
        asm volatile("" : "+v"(fr));
        const int col0 = u.pn * BM + wc * 64 + 16 * fq;
#pragma unroll
        for (int ai = 0; ai < 2; ++ai)
#pragma unroll
            for (int m = 0; m < 4; ++m) { const int r = ai * HALF + wr * 64 + m * 16 + fr; const float sc = (scaled ? __uint_as_float(meta[r]) : 1.f) * (u.pn < qtiles ? qscale : 1.f); bf16_t* rowp = O + (size_t)(u.pm * BM + r) * ldc + col0;
#pragma unroll
                for (int bj = 0; bj < 2; ++bj) { const f32x4 v0 = acc[ai][bj][m][0] * sc, v1 = acc[ai][bj][m][1] * sc;
                    u32x4 w; w.x = pk2(v0[0], v0[1]); w.y = pk2(v0[2], v0[3]); w.z = pk2(v1[0], v1[1]); w.w = pk2(v1[2], v1[3]);
                    *(u32x4*)(rowp + 8 * bj) = w; } }
    }
};
struct EpiX1 {
    static constexpr bool PERM = false;
    const float* x; float* out;
    DI void operator()(const f32x4 (&acc)[2][2][4][2], const SchedStatic::Unit& u, const LAS unsigned* meta, int wr, int wc, int fr, int fq) const {
        asm volatile("" : "+v"(fr));
        const int row0 = u.pm * BM + wr * 64 + fr, col0 = u.pn * BM + wc * 32 + 4 * fq;
#pragma unroll
        for (int ai = 0; ai < 2; ++ai) { f32x4 xv[4][2][2];
#pragma unroll
            for (int m = 0; m < 4; ++m) { const size_t rb = (size_t)(row0 + ai * HALF + m * 16) * DM + col0;
#pragma unroll
                for (int bj = 0; bj < 2; ++bj)
#pragma unroll
                    for (int n = 0; n < 2; ++n) xv[m][bj][n] = *(const f32x4*)(x + rb + bj * HALF + n * 16); }
            asm volatile("" ::: "memory");
#pragma unroll
            for (int m = 0; m < 4; ++m) { const size_t rb = (size_t)(row0 + ai * HALF + m * 16) * DM + col0;
#pragma unroll
                for (int bj = 0; bj < 2; ++bj)
#pragma unroll
                    for (int n = 0; n < 2; ++n) *(f32x4*)(out + rb + bj * HALF + n * 16) = xv[m][bj][n] + acc[ai][bj][m][n]; }
            asm volatile("" ::: "memory"); }
    }
};
struct EpiGU {
    static constexpr bool PERM = true;
    unsigned char* hid;
    DI void operator()(const f32x4 (&acc)[2][2][4][2], const MoeUnit& u, const LAS unsigned* meta, int wr, int wc, int fr, int fq) const {
        asm volatile("" : "+v"(fr));
        typedef float f32x2 __attribute__((ext_vector_type(2)));
        const unsigned coloff = (unsigned)u.gt * 256u * (unsigned)DEXP + (unsigned)(u.sub * 128 + wc * 32 + 8 * fq);
        float rsv[2][4];
#pragma unroll
        for (int ai = 0; ai < 2; ++ai)
#pragma unroll
            for (int m = 0; m < 4; ++m) rsv[ai][m] = __uint_as_float(meta[ai * HALF + wr * 64 + m * 16 + fr]);
#pragma unroll
        for (int ai = 0; ai < 2; ++ai)
#pragma unroll
            for (int m = 0; m < 4; ++m) { const int r = ai * HALF + wr * 64 + m * 16 + fr;
                const float rs = rsv[ai][m] * (1.f / 32.f);
                const float ct = rs * -1.4426950408889634f, cm = rs * rs * 8.f;
                f32x2 h[4];
#pragma unroll
                for (int n = 0; n < 2; ++n)
#pragma unroll
                    for (int q = 0; q < 2; ++q) { const f32x2 g = {acc[ai][0][m][n][2 * q], acc[ai][0][m][n][2 * q + 1]}, uu = {acc[ai][1][m][n][2 * q], acc[ai][1][m][n][2 * q + 1]};
                        const f32x2 t = g * ct; f32x2 d = {__builtin_amdgcn_exp2f(t.x), __builtin_amdgcn_exp2f(t.y)}; d = d + 1.f;
                        const f32x2 rc = {__builtin_amdgcn_rcpf(d.x), __builtin_amdgcn_rcpf(d.y)};
                        h[n * 2 + q] = ((g * uu) * cm) * rc; }
                u32x2 w; w.x = pk4_fp8(h[0].x, h[0].y, h[1].x, h[1].y); w.y = pk4_fp8(h[2].x, h[2].y, h[3].x, h[3].y);
                *(u32x2*)(hid + ((unsigned)r * (unsigned)DEXP + coloff)) = w;
                asm volatile("" ::: "memory"); }
    }
};
struct EpiDownR {
    static constexpr bool PERM = true;
    unsigned char* y8; unsigned char* y8s;
    DI void operator()(const f32x4 (&acc)[2][2][4][2], const MoeUnit& u, const LAS unsigned* meta, int wr, int wc, int fr, int fq) const {
        asm volatile("" : "+v"(fr));
        unsigned char* base = u.e == NEXP ? y8s : y8; const unsigned coloff = (unsigned)(u.sub * 256 + wc * 64 + 16 * fq);
        const unsigned sinkrow = (u.e == NEXP ? (unsigned)T_TOK : (unsigned)T_TOK * 8u) + (unsigned)fr;
        unsigned pp[2][4]; float gg[2][4];
#pragma unroll
        for (int ai = 0; ai < 2; ++ai)
#pragma unroll
            for (int m = 0; m < 4; ++m) { const int r = ai * HALF + wr * 64 + m * 16 + fr; pp[ai][m] = meta[r]; gg[ai][m] = __uint_as_float(meta[256 + r]); }
#pragma unroll
        for (int ai = 0; ai < 2; ++ai)
#pragma unroll
            for (int m = 0; m < 4; ++m) { const int r = ai * HALF + wr * 64 + m * 16 + fr;
                { unsigned p = pp[ai][m]; const float gw = gg[ai][m] * (1.f / 128.f);
                    p = r < u.nvalid ? p : sinkrow;
                    unsigned char* rowp = base + (p * (unsigned)DM + coloff);
                    const f32x4 v0 = acc[ai][0][m][0] * gw, v1 = acc[ai][0][m][1] * gw, v2 = acc[ai][1][m][0] * gw, v3 = acc[ai][1][m][1] * gw;
                    u32x4 w; w.x = pk4_fp8(v0[0], v0[1], v0[2], v0[3]); w.y = pk4_fp8(v1[0], v1[1], v1[2], v1[3]); w.z = pk4_fp8(v2[0], v2[1], v2[2], v2[3]); w.w = pk4_fp8(v3[0], v3[1], v3[2], v3[3]);
                    __builtin_nontemporal_store(w, (u32x4*)rowp); }
                asm volatile("" ::: "memory"); }
    }
};
}

struct Ctx {
    unsigned char* lds_generic; LAS unsigned char* lds;
    int tid, lane, wid, G, vcu, xcd;
    float* out; unsigned char* ws;
};
struct Args { const float* in[28]; float* out; unsigned char* ws; int ph_lo, ph_hi, flags, pad; };

DI const float* in_ptr(int i) {
    const __attribute__((address_space(4))) char* ka = (const __attribute__((address_space(4))) char*)__builtin_amdgcn_kernarg_segment_ptr();
    unsigned off = (unsigned)i * 8u; asm volatile("" : "+s"(off));
    return *(const float* const __attribute__((address_space(4)))*)(ka + off);
}
DI void tr_item(const float* W, int ldn, int k0, int n0, bf16_t* WT, size_t drow0, int ldk, const float* scale, LAS float* scr, int lane, bool spread = false) {
    float wv[32];
    const float* wp = W + (size_t)(k0 + (lane >> 5)) * ldn + n0 + (lane & 31);
#pragma unroll
    for (int i = 0; i < 32; ++i) wv[i] = __builtin_nontemporal_load(wp + (size_t)(2 * i) * ldn);
    if (scale) {
#pragma unroll
        for (int i = 0; i < 32; ++i) wv[i] *= scale[2 * i + (lane >> 5)];
    }
#pragma unroll
    for (int i = 0; i < 32; ++i) scr[(2 * i + (lane >> 5)) * 33 + (lane & 31)] = wv[i];
    LDS_WAIT(); asm volatile("" ::: "memory");
    const int c = lane & 7;
#pragma unroll
    for (int j = 0; j < 4; ++j) { const int n = (lane >> 3) + 8 * j; const LAS float* s = scr + (8 * c) * 33 + n;
        u32x4 o; o.x = pk2(s[0 * 33], s[1 * 33]); o.y = pk2(s[2 * 33], s[3 * 33]); o.z = pk2(s[4 * 33], s[5 * 33]); o.w = pk2(s[6 * 33], s[7 * 33]);
        *(u32x4*)(WT + (drow0 + (spread ? 16 * (n >> 3) + (n & 7) : n)) * (size_t)ldk + k0 + 8 * c) = o; }
    LDS_WAIT(); asm volatile("" ::: "memory");
}
DI void tr_item8(const float* W, int ldn, int k0, int n0, unsigned char* WT, size_t drow0, int ldk, const float* scale, float mul, LAS float* scr, int lane, bool spread) {
    float wv[32];
    const float* wp = W + (size_t)(k0 + (lane >> 5)) * ldn + n0 + (lane & 31);
#pragma unroll
    for (int i = 0; i < 32; ++i) wv[i] = __builtin_nontemporal_load(wp + (size_t)(2 * i) * ldn);
#pragma unroll
    for (int i = 0; i < 32; ++i) wv[i] *= (scale ? scale[2 * i + (lane >> 5)] : 1.f) * mul;
#pragma unroll
    for (int i = 0; i < 32; ++i) scr[(2 * i + (lane >> 5)) * 33 + (lane & 31)] = wv[i];
    LDS_WAIT(); asm volatile("" ::: "memory");
    const int c = lane & 3;
#pragma unroll
    for (int j = 0; j < 2; ++j) { const int n = (lane >> 2) + 16 * j; const LAS float* sp = scr + (16 * c) * 33 + n;
        u32x4 o;
#pragma unroll
        for (int q = 0; q < 4; ++q) o[q] = pk4_fp8(sp[(4 * q) * 33], sp[(4 * q + 1) * 33], sp[(4 * q + 2) * 33], sp[(4 * q + 3) * 33]);
        *(u32x4*)(WT + (drow0 + (spread ? 16 * (n >> 3) + (n & 7) : n)) * (size_t)ldk + k0 + 16 * c) = o; }
    LDS_WAIT(); asm volatile("" ::: "memory");
}
DI void p0_prologue(const Ctx& C) {
    LAS float* scr = (LAS float*)(C.lds + C.wid * 16384);
    const int gw = C.vcu * 8 + C.wid, NGW = C.G * 8, lane = C.lane;
    bf16_t* W1T = (bf16_t*)(C.ws + WS_W1T); bf16_t* W2T = (bf16_t*)(C.ws + WS_W2T); bf16_t* WMT = (bf16_t*)(C.ws + WS_WMT);
    unsigned char* WGU = C.ws + WS_WGU; unsigned char* WD = C.ws + WS_WD;
    constexpr int I_IN = 16 * 72, I_OUT = 16 * 32, I_MEM = 16 * 16, I_G = 16 * 8, I_D = 4 * 32;
    constexpr int NITEMS = I_IN + I_OUT + I_MEM + 65 * (2 * I_G + I_D);
    for (int it = gw; it < NITEMS; it += NGW) {
        int r = it;
        if (r < I_IN) { const int kb = r / 72, nb = r % 72; tr_item(in_ptr(4), DIN, 64 * kb, 32 * nb, W1T, (size_t)32 * nb, DM, in_ptr(2) + 64 * kb, scr, lane); continue; } r -= I_IN;
        if (r < I_OUT) { const int kb = r / 32, nb = r % 32, k0 = 64 * kb; const float* sc = k0 < 512 ? in_ptr(15) + k0 : (k0 < 768 ? in_ptr(16) + (k0 - 512) : in_ptr(17) + (k0 - 768));
            tr_item(in_ptr(18), DM, k0, 32 * nb, W2T, (size_t)32 * nb, DM, sc, scr, lane); continue; } r -= I_OUT;
        if (r < I_MEM) { const int kb = r / 16, nb = r % 16; tr_item(in_ptr(12), 512, 64 * kb, 32 * nb, WMT, (size_t)32 * nb, DM, in_ptr(3) + 64 * kb, scr, lane); continue; } r -= I_MEM;
        const int e = r / (2 * I_G + I_D); r -= e * (2 * I_G + I_D);
        if (r < 2 * I_G) { const int up = r >= I_G; if (up) r -= I_G; const int kb = r / 8, nb = r % 8, n0 = 32 * nb;
            const float* src = e < NEXP ? (up ? in_ptr(23) : in_ptr(22)) + (size_t)e * DM * DEXP : (up ? in_ptr(26) : in_ptr(25));
            const size_t drow0 = (size_t)e * 512 + (n0 >> 7) * 256 + 64 * ((n0 & 127) >> 5) + (up ? 8 : 0);
            tr_item8(src, DEXP, 64 * kb, n0, WGU, drow0, DM, in_ptr(19) + 64 * kb, 32.f, scr, lane, true); continue; }
        r -= 2 * I_G;
        { const int kb = r / 32, nb = r % 32; const float* src = e < NEXP ? in_ptr(24) + (size_t)e * DEXP * DM : in_ptr(27);
          tr_item8(src, DM, 64 * kb, 32 * nb, WD, (size_t)e * 1024 + 32 * nb, DEXP, nullptr, 16.f, scr, lane, false); }
    }
    { bf16_t* WRH = (bf16_t*)(C.ws + WS_WRHI); bf16_t* WRL = (bf16_t*)(C.ws + WS_WRLO);
      for (int idx = (C.vcu * 512 + C.tid); idx < DM * NEXP; idx += C.G * 512) { const int k = idx >> 6, n = idx & 63; const float v = in_ptr(20)[idx] * in_ptr(19)[k];
          const bf16_t h = f2bf(v); const bf16_t l = f2bf(v - bf2f(h)); const int c = k & 31, pk = (k & ~31) + 8 * ((c & 15) >> 2) + 4 * (c >> 4) + (c & 3);
          WRH[n * DM + pk] = h; WRL[n * DM + pk] = l; } }
    { u32x4* RGW = (u32x4*)(C.ws + WS_RGW);
      for (int idx = C.vcu * 512 + C.tid; idx < 2 * 4 * 8 * 64; idx += C.G * 512) { const int ln = idx & 63, f = (idx >> 6) & 7, n = (idx >> 9) & 3, mat = idx >> 11; const int nb = f >> 1, kc = f & 1;
          const float* w = (mat ? in_ptr(9) : in_ptr(7)) + (size_t)n * 4096; const int c0 = 32 * kc + 8 * (ln >> 4), d = 16 * nb + (ln & 15);
          u32x4 o; o.x = pk2(w[(c0 + 0) * 64 + d], w[(c0 + 1) * 64 + d]); o.y = pk2(w[(c0 + 2) * 64 + d], w[(c0 + 3) * 64 + d]); o.z = pk2(w[(c0 + 4) * 64 + d], w[(c0 + 5) * 64 + d]); o.w = pk2(w[(c0 + 6) * 64 + d], w[(c0 + 7) * 64 + d]);
          RGW[idx] = o; } }
    { bf16_t* XB = (bf16_t*)(C.ws + WS_XB); float* R1 = (float*)(C.ws + WS_RINV1); bf16_t* MN = (bf16_t*)(C.ws + WS_MEMN);
      for (int m0 = gw; m0 < T_TOK + NMEM; m0 += 2 * NGW) {
          f32x4 v[2][4]; float ssq[2];
#pragma unroll
          for (int u = 0; u < 2; ++u) { const int m = m0 + u * NGW; const bool ok = m < T_TOK + NMEM; const int mm = ok ? m : gw;
              const bool ismem = mm >= T_TOK; const float* src = ismem ? in_ptr(1) + (size_t)(mm - T_TOK) * DM : in_ptr(0) + (size_t)mm * DM;
              const f32x4* xr = (const f32x4*)src + lane;
#pragma unroll
              for (int j = 0; j < 4; ++j) v[u][j] = __builtin_nontemporal_load(xr + 64 * j); }
#pragma unroll
          for (int u = 0; u < 2; ++u) { float s_ = 0.f;
#pragma unroll
              for (int j = 0; j < 4; ++j) s_ += (v[u][j].x * v[u][j].x + v[u][j].y * v[u][j].y) + (v[u][j].z * v[u][j].z + v[u][j].w * v[u][j].w);
              ssq[u] = s_; }
#pragma unroll
          for (int u = 0; u < 2; ++u) { const int m = m0 + u * NGW; if (m >= T_TOK + NMEM) continue;
              const bool ismem = m >= T_TOK;
              const float rinv = __builtin_amdgcn_rsqf(wave_sum(ssq[u]) * (1.f / DM) + RMS_EPS);
              const float mul = ismem ? rinv : 1.f;
              bf16_t* dst = ismem ? MN + (size_t)(m - T_TOK) * DM : XB + (size_t)m * DM;
              u32x2* o8 = (u32x2*)dst + lane;
#pragma unroll
              for (int j = 0; j < 4; ++j) { u32x2 w; w.x = pk2(v[u][j].x * mul, v[u][j].y * mul); w.y = pk2(v[u][j].z * mul, v[u][j].w * mul); o8[64 * j] = w; }
              if (!ismem && lane == 0) R1[m] = rinv; }
      } }
}

typedef short v4i16_t __attribute__((ext_vector_type(4)));
DI v4i16_t tr_read(const LAS bf16_t* p) { return __builtin_amdgcn_ds_read_tr16_b64_v4i16((LAS v4i16_t*)p); }
DI bf16x8 v_frag(const LAS bf16_t* vblk, int s, int dh, int lane) {
    const int h = lane >> 5, g = (lane >> 4) & 1, q4 = (lane & 15) >> 2, p4 = lane & 3;
    const LAS bf16_t* p = vblk + (16 * s + 4 * h + q4) * 72 + 32 * dh + 16 * g + 4 * p4;
    const v4i16_t lo = tr_read(p), hi = tr_read(p + 8 * 72);
    return (bf16x8){lo[0], lo[1], lo[2], lo[3], hi[0], hi[1], hi[2], hi[3]};
}
struct SbPre { bf16x8 q[4], k[4]; u32x4 v[4]; };
DI void sb_prefetch(SbPre& P, const bf16_t* proj, int u, int wid, int lane) {
    const int qb = u & 15, hd = (u >> 4) & 7, b = u >> 7; const int r = lane & 31, h = lane >> 5; const int t0 = qb * 256 + wid * 32; const size_t rowb = (size_t)b * SEQ;
    const bf16_t* qp = proj + (rowb + t0 + r) * DIN + COL_Q + hd * 64 + 8 * h; const bf16_t* kp = proj + (rowb + t0 + r) * DIN + COL_K + hd * 64 + 8 * h;
    const u32x4* vp = (const u32x4*)(proj + (rowb + t0 + (lane >> 1)) * DIN + COL_V + hd * 64 + (lane & 1) * 32);
#pragma unroll
    for (int c = 0; c < 4; ++c) { P.q[c] = *(const bf16x8*)(qp + 16 * c); P.k[c] = *(const bf16x8*)(kp + 16 * c); P.v[c] = vp[c]; }
}
DI void sb_unit(const bf16_t* proj, bf16_t* obuf, LAS bf16_t* vs, int u, int unext, SbPre& pre, int wid, int lane) {
    const int qb = u & 15, hd = (u >> 4) & 7, b = u >> 7;
    const int r = lane & 31, h = lane >> 5;
    const int t0 = qb * 256 + wid * 32;
    const size_t rowb = (size_t)b * SEQ;
    bf16x8 qf[4];
#pragma unroll
    for (int c = 0; c < 4; ++c) qf[c] = pre.q[c];
    f32x16 o0, o1;
#pragma unroll
    for (int i = 0; i < 16; ++i) { o0[i] = 0.f; o1[i] = 0.f; }
    float R = 0.f;
    const int tq = t0 + r;
    const int vrow = lane >> 1, vc0 = (lane & 1) * 32;
    bf16x8 kf[4]; u32x4 vr[4];
#pragma unroll
    for (int c = 0; c < 4; ++c) { kf[c] = pre.k[c]; vr[c] = pre.v[c]; }
    if (unext >= 0) { sb_prefetch(pre, proj, unext, wid, lane); asm volatile("" ::: "memory"); }
#define SB_LOAD(kbx) do { const bf16_t* kp_ = proj + (rowb + (kbx) * 32 + r) * DIN + COL_K + hd * 64 + 8 * h; \
        _Pragma("unroll") for (int c = 0; c < 4; ++c) kf[c] = *(const bf16x8*)(kp_ + 16 * c); \
        const u32x4* vp_ = (const u32x4*)(proj + (rowb + (kbx) * 32 + vrow) * DIN + COL_V + hd * 64 + vc0); \
        _Pragma("unroll") for (int c = 0; c < 4; ++c) vr[c] = vp_[c]; } while (0)
    for (int kb = t0 >> 5; kb >= 0; --kb) {
        const int s0 = kb * 32;
        f32x16 p;
#pragma unroll
        for (int i = 0; i < 16; ++i) p[i] = 0.f;
#pragma unroll
        for (int c = 0; c < 4; ++c) p = MFMA32(kf[c], qf[c], p);
        { LAS u32x4* dst = (LAS u32x4*)(vs + vrow * 72 + vc0);
#pragma unroll
          for (int c = 0; c < 4; ++c) dst[c] = vr[c]; }
        asm volatile("" ::: "memory");
        SB_LOAD(kb > 0 ? kb - 1 : 0);
        float cs[16], Tg[4], Pg[4], Eg[4], w[16];
        const bool diag = (kb == (t0 >> 5));
        if (diag) {
#pragma unroll
            for (int g = 0; g < 4; ++g) { float run = 0.f;
#pragma unroll
                for (int j = 3; j >= 0; --j) { const int i = 4 * g + j; const bool valid = s0 + crow(i, h) < tq; const float zz = p[i];
                    const float sp = fmaxf(zz, 0.f) + __builtin_amdgcn_logf(1.f + __builtin_amdgcn_exp2f(-fabsf(zz)));
                    run += valid ? -sp : 0.f; cs[i] = run; }
                Tg[g] = run; }
        } else {
#pragma unroll
            for (int g = 0; g < 4; ++g) { float run = 0.f;
#pragma unroll
                for (int j = 3; j >= 0; --j) { const int i = 4 * g + j; const float zz = p[i];
                    run -= fmaxf(zz, 0.f) + __builtin_amdgcn_logf(1.f + __builtin_amdgcn_exp2f(-fabsf(zz))); cs[i] = run; }
                Tg[g] = run; }
        }
#pragma unroll
        for (int g = 0; g < 4; ++g) Pg[g] = __shfl_xor(Tg[g], 32);
        float after = 0.f;
#pragma unroll
        for (int g = 3; g >= 0; --g) { Eg[g] = after + (h == 0 ? Pg[g] : 0.f) + R; after += Tg[g] + Pg[g]; }
        if (diag) {
#pragma unroll
            for (int i = 0; i < 16; ++i) { const bool valid = s0 + crow(i, h) < tq; w[i] = valid ? __builtin_amdgcn_exp2f(p[i] + cs[i] + Eg[i >> 2]) : 0.f; }
        } else {
#pragma unroll
            for (int i = 0; i < 16; ++i) w[i] = __builtin_amdgcn_exp2f(p[i] + cs[i] + Eg[i >> 2]);
        }
        R += after;
#pragma unroll
        for (int s = 0; s < 2; ++s) {
            u32x4 xw; xw.x = pk2(w[8 * s + 0], w[8 * s + 1]); xw.y = pk2(w[8 * s + 2], w[8 * s + 3]); xw.z = pk2(w[8 * s + 4], w[8 * s + 5]); xw.w = pk2(w[8 * s + 6], w[8 * s + 7]);
            const bf16x8 xs = __builtin_bit_cast(bf16x8, xw);
            o0 = MFMA32(xs, v_frag(vs, s, 0, lane), o0);
            o1 = MFMA32(xs, v_frag(vs, s, 1, lane), o1);
        }
        asm volatile("" ::: "memory");
        if (__all(R < -64.f)) break;
    }
#undef SB_LOAD
#pragma unroll
    for (int i = 0; i < 16; ++i) { bf16_t* op = obuf + (rowb + t0 + crow(i, h)) * DM + hd * 64 + r; op[0] = f2bf(o0[i]); op[32] = f2bf(o1[i]); }
}
DI void ca_unit(const Ctx& C, const bf16_t* proj, const bf16_t* kvm, const float* qg, const float* kg, bf16_t* obuf, int b, int hd, int qb, const bool stage) {
    const int lane = C.lane, wid = C.wid, tid = C.tid;
    LAS bf16_t* Kn = (LAS bf16_t*)C.lds; LAS bf16_t* Vs = (LAS bf16_t*)(C.lds + 36864); LAS unsigned* kmax2 = (LAS unsigned*)(C.lds + 73728);
    if (stage) {
    __syncthreads();
    if (tid == 0) *kmax2 = 0u;
    __syncthreads();
    { const int chunk = tid & 7; float gk[8];
#pragma unroll
      for (int j = 0; j < 8; ++j) gk[j] = kg[8 * chunk + j];
#pragma unroll
      for (int it = 0; it < 4; ++it) { const int row = it * 64 + (tid >> 3);
          const bf16_t* src = kvm + ((size_t)b * MEMLEN + row) * 512 + hd * 64 + 8 * chunk;
          const u32x4 kr = *(const u32x4*)src, vr = *(const u32x4*)(src + 256);
          float kv[8]; float ss = 0.f;
#pragma unroll
          for (int q = 0; q < 4; ++q) { kv[2 * q] = bflo(kr[q]); kv[2 * q + 1] = bfhi(kr[q]); ss += kv[2 * q] * kv[2 * q] + kv[2 * q + 1] * kv[2 * q + 1]; }
          ss += __shfl_xor(ss, 1); ss += __shfl_xor(ss, 2); ss += __shfl_xor(ss, 4);
          const float rk = __builtin_amdgcn_rsqf(ss * (1.f / 64.f) + RMS_EPS);
          float n2 = 0.f; u32x4 w;
#pragma unroll
          for (int q = 0; q < 4; ++q) { const float a_ = kv[2 * q] * rk * gk[2 * q], b_ = kv[2 * q + 1] * rk * gk[2 * q + 1]; n2 += a_ * a_ + b_ * b_; w[q] = pk2(a_, b_); }
          n2 += __shfl_xor(n2, 1); n2 += __shfl_xor(n2, 2); n2 += __shfl_xor(n2, 4);
          *(LAS u32x4*)(Kn + row * 72 + 8 * chunk) = w; *(LAS u32x4*)(Vs + row * 72 + 8 * chunk) = vr;
          if (chunk == 0) __hip_atomic_fetch_max(kmax2, __float_as_uint(n2), __ATOMIC_RELAXED, __HIP_MEMORY_SCOPE_WORKGROUP); } }
    __syncthreads();
    }
    const int r = lane & 31, h = lane >> 5;
    const int t0 = qb * 256 + wid * 32;
    const size_t rowb = (size_t)b * SEQ;
    bf16x8 qf[4]; float mq;
    { const bf16_t* qp = proj + (rowb + t0 + r) * DIN + COL_QCA + hd * 64 + 8 * h;
      float qv[4][8]; float ss = 0.f;
#pragma unroll
      for (int c = 0; c < 4; ++c) { const u32x4 raw = *(const u32x4*)(qp + 16 * c);
#pragma unroll
          for (int q = 0; q < 4; ++q) { qv[c][2 * q] = bflo(raw[q]); qv[c][2 * q + 1] = bfhi(raw[q]); ss += qv[c][2 * q] * qv[c][2 * q] + qv[c][2 * q + 1] * qv[c][2 * q + 1]; } }
      ss += __shfl_xor(ss, 32);
      const float rq = (__builtin_amdgcn_rsqf(ss * (1.f / 64.f) + RMS_EPS)) * (0.125f * 1.4426950408889634f);
      float n2 = 0.f;
#pragma unroll
      for (int c = 0; c < 4; ++c) { const float* g = qg + 16 * c + 8 * h; u32x4 w;
#pragma unroll
          for (int q = 0; q < 4; ++q) { const float a_ = qv[c][2 * q] * rq * g[2 * q], b_ = qv[c][2 * q + 1] * rq * g[2 * q + 1]; n2 += a_ * a_ + b_ * b_; w[q] = pk2(a_, b_); }
          qf[c] = __builtin_bit_cast(bf16x8, w); }
      n2 += __shfl_xor(n2, 32);
      mq = sqrtf(n2 * __uint_as_float(*kmax2)) * 1.01f; }
    float l = 0.f;
    f32x16 o0, o1;
#pragma unroll
    for (int i = 0; i < 16; ++i) { o0[i] = 0.f; o1[i] = 0.f; }
#pragma unroll 2
    for (int kb = 0; kb < 8; ++kb) {
        f32x16 p;
#pragma unroll
        for (int i = 0; i < 16; ++i) p[i] = 0.f;
        const LAS bf16_t* kp = Kn + (kb * 32 + r) * 72 + 8 * h;
#pragma unroll
        for (int c = 0; c < 4; ++c) p = MFMA32(*(const LAS bf16x8*)(kp + 16 * c), qf[c], p);
#pragma unroll
        for (int i = 0; i < 16; ++i) { const float e = __builtin_amdgcn_exp2f(p[i] - mq); p[i] = e; l += e; }
        const LAS bf16_t* vblk = Vs + kb * 32 * 72;
#pragma unroll
        for (int s = 0; s < 2; ++s) {
            u32x4 xw;
#pragma unroll
            for (int q = 0; q < 4; ++q) xw[q] = pk2(p[8 * s + 2 * q], p[8 * s + 2 * q + 1]);
            const bf16x8 xs = __builtin_bit_cast(bf16x8, xw);
            o0 = MFMA32(xs, v_frag(vblk, s, 0, lane), o0);
            o1 = MFMA32(xs, v_frag(vblk, s, 1, lane), o1);
        }
    }
    l += __shfl_xor(l, 32);
    const float inv = __builtin_amdgcn_rcpf(l);
#pragma unroll
    for (int i = 0; i < 16; ++i) { const float iv = __shfl(inv, crow(i, h)); bf16_t* op = obuf + (rowb + t0 + crow(i, h)) * DM + 768 + hd * 64 + r; op[0] = f2bf(o0[i] * iv); op[32] = f2bf(o1[i] * iv); }
}
DI float neg_expm1(float x) {
    if (x > -0.25f) { return -x * (1.f + x * (0.5f + x * (0.16666667f + x * (0.041666668f + x * (0.0083333338f + x * 0.0013888889f))))); }
    return 1.f - __expf(x);
}
DI float gelu_tanh(float x) { const float y = 0.7978845608f * (x + 0.044715f * x * x * x); const float t = 1.f - 2.f * __builtin_amdgcn_rcpf(__builtin_amdgcn_exp2f(y * 2.8853900817779268f) + 1.f); return 0.5f * x * (1.f + t); }
template <bool PASS2>
DI void rg_wave(const Ctx& C, int b, int chunk, LAS unsigned char* wscr, LAS float* ssq) {
    const int lane = C.lane, n = C.wid & 3, half = C.wid >> 2, ch = 64 * n + lane;
    const bf16_t* proj = (const bf16_t*)(C.ws + WS_PROJ);
    float* seg = (float*)(C.ws + WS_SEG);
    bf16_t* obuf = (bf16_t*)(C.ws + WS_O); unsigned* hlp = (unsigned*)(C.ws + WS_HLP);
    const int tl0 = half * 128, t_start = chunk * 256 + tl0, sidx = chunk * 2 + half;
    const size_t rowb = (size_t)b * SEQ;
    const float cw0 = in_ptr(5)[0 * 256 + ch], cw1 = in_ptr(5)[1 * 256 + ch], cw2 = in_ptr(5)[2 * 256 + ch], cw3 = in_ptr(5)[3 * 256 + ch], cb = in_ptr(6)[ch];
    const float brg = in_ptr(8)[ch], big = in_ptr(10)[ch];
    const float lam = in_ptr(11)[ch];
    const float c8 = -8.f * (fmaxf(-lam, 0.f) + __logf(1.f + __expf(-fabsf(lam))));
    bf16x8 wrf[4][2], wif[4][2];
    { const bf16x8* fr_ = (const bf16x8*)(C.ws + WS_RGW) + (size_t)(n * 8) * 64 + lane; const bf16x8* fi_ = fr_ + 4 * 8 * 64;
#pragma unroll
      for (int nb = 0; nb < 4; ++nb)
#pragma unroll
          for (int kc = 0; kc < 2; ++kc) { wrf[nb][kc] = fr_[(nb * 2 + kc) * 64]; wif[nb][kc] = fi_[(nb * 2 + kc) * 64]; } }
    float hst = 0.f, aprod = 1.f;
    if (PASS2) {
        const float* sp = seg + ((size_t)b * 32 * 256 + ch) * 2;
#pragma unroll 4
        for (int s = 0; s < sidx; ++s) { const f32x2 v = *(const f32x2*)(sp + (size_t)s * 512); hst = v.x * hst + v.y; }
    }
    float x3 = 0.f, x2 = 0.f, x1 = 0.f;
    if (t_start > 0) { const bf16_t* xp = proj + (rowb + t_start - 3) * DIN + COL_XRG + ch; x3 = bf2f(xp[0]); x2 = bf2f(xp[DIN]); x1 = bf2f(xp[2 * DIN]); }
    LAS bf16_t* At = (LAS bf16_t*)wscr;
    LAS float* Pr = (LAS float*)(wscr + 2304);
    LAS float* Pi = (LAS float*)(wscr + 2304 + 4096);
    LAS float* Xc = (LAS float*)(wscr + 2304 + 8192);
    bf16_t xq[16], gq[16];
#define RG_LOAD(sub_) do { const bf16_t* xp_ = proj + (rowb + t_start + (sub_) * 16) * DIN + COL_XRG + ch; \
        _Pragma("unroll") for (int tt = 0; tt < 16; ++tt) xq[tt] = xp_[(size_t)tt * DIN]; \
        if (PASS2) { _Pragma("unroll") for (int tt = 0; tt < 16; ++tt) gq[tt] = xp_[(size_t)tt * DIN + (COL_GRG - COL_XRG)]; } } while (0)
    RG_LOAD(0);
    const float c8l = c8 * 1.4426950408889634f;
    for (int sub = 0; sub < 8; ++sub) {
        const int tb = t_start + sub * 16;
        float gcur[16];
#pragma unroll
        for (int tt = 0; tt < 16; ++tt) { const float x0 = bf2f(xq[tt]);
            const float v = cb + cw0 * x3 + cw1 * x2 + cw2 * x1 + cw3 * x0; Xc[tt * 64 + lane] = v; x3 = x2; x2 = x1; x1 = x0; At[tt * 72 + lane] = f2bf(v); if (PASS2) gcur[tt] = bf2f(gq[tt]); }
        RG_LOAD(sub < 7 ? sub + 1 : 7);
        LDS_WAIT(); asm volatile("" ::: "memory");
        bf16x8 af[2];
#pragma unroll
        for (int kc = 0; kc < 2; ++kc) af[kc] = *(const LAS bf16x8*)(At + (lane & 15) * 72 + 32 * kc + 8 * (lane >> 4));
#pragma unroll
        for (int nb = 0; nb < 4; ++nb) { f32x4 ar = {0.f, 0.f, 0.f, 0.f}, ai = {0.f, 0.f, 0.f, 0.f};
#pragma unroll
            for (int kc = 0; kc < 2; ++kc) { ar = MFMA16(af[kc], wrf[nb][kc], ar); ai = MFMA16(af[kc], wif[nb][kc], ai); }
#pragma unroll
            for (int q = 0; q < 4; ++q) { const int t = 4 * (lane >> 4) + q, d = 16 * nb + (lane & 15); Pr[t * 64 + d] = ar[q]; Pi[t * 64 + d] = ai[q]; } }
        LDS_WAIT(); asm volatile("" ::: "memory");
#pragma unroll
        for (int tt = 0; tt < 16; ++tt) {
            const float rr = sigmoidf_(Pr[tt * 64 + lane] + brg), ii = sigmoidf_(Pi[tt * 64 + lane] + big);
            const float a = __builtin_amdgcn_exp2f(c8l * rr), mult = __builtin_amdgcn_sqrtf(fmaxf(1.f - a * a, 0.f));
            hst = a * hst + mult * ii * Xc[tt * 64 + lane]; aprod *= a;
            if (!PASS2) hlp[(rowb + tb + tt) * 256 + ch] = pk2(hst, aprod);
            if (PASS2) { const size_t row = rowb + tb + tt; const float o = gelu_tanh(gcur[tt]) * hst;
                obuf[row * DM + 512 + ch] = f2bf(o); }
        }
        LDS_WAIT(); asm volatile("" ::: "memory");
    }
#undef RG_LOAD
    if (!PASS2) { *(f32x2*)(seg + (((size_t)b * 32 + sidx) * 256 + ch) * 2) = (f32x2){aprod, hst}; }
}
constexpr int CW_MEMF = 12304;
DI void p2_mixers(const Ctx& C, int pflags, LAS unsigned* tab, const bool grp) {
    const bf16_t* proj = (const bf16_t*)(C.ws + WS_PROJ); const bf16_t* kvm = (const bf16_t*)(C.ws + WS_KVM); bf16_t* obuf = (bf16_t*)(C.ws + WS_O);
    constexpr int N_RG = 256, N_CA = NBATCH * 4 * 16, N_SB = NBATCH * 8 * 16, N_MEMU = (NMEM / 256) * 2, SB_MEM = 5;
    unsigned* memf = (unsigned*)(C.ws + WS_CTL) + CW_MEMF;
    const bool memcu = (int)blockIdx.x < N_MEMU;
    { pg8::SchedStatic S; S.init(NMEM, 512, DM, C.G, (int)blockIdx.x, C.ws + WS_WMT, nullptr);
      pg8::EpiRowScaleBf16 E{(bf16_t*)(C.ws + WS_KVM), 512, false, 1.f, 0};
      pg8::gemm_phase<false>(C.lds, tab, (const char*)(C.ws + WS_MEMN), DM * 2, S, E);
      if (memcu) { __syncthreads(); if (C.tid == 0) { __builtin_amdgcn_fence(__ATOMIC_RELEASE, "agent"); (void)xb_add(memf, 1u); } } }
    __syncthreads();
    for (int L = C.vcu; L < N_RG; L += C.G) if (!(pflags & 2)) rg_wave<false>(C, L >> 4, L & 15, C.lds + C.wid * 15360, nullptr);
    if (!(pflags & 8)) {
        int first, stride, nsb;
        if (grp) { const int x_ = (int)blockIdx.x & 7, m_ = (int)blockIdx.x >> 3;
            if (m_ < 4) { first = 256 * x_ + SB_MEM * m_; stride = 1; nsb = SB_MEM; }
            else { const int j0 = 4 * SB_MEM + (m_ - 4); first = 256 * x_ + j0; stride = 28; nsb = (256 - j0 + 27) / 28; } }
        else if (C.G > N_MEMU) { if (memcu) { first = (int)blockIdx.x * SB_MEM; stride = 1; nsb = SB_MEM; }
                            else { first = N_MEMU * SB_MEM + ((int)blockIdx.x - N_MEMU); stride = C.G - N_MEMU; nsb = (N_SB - first + stride - 1) / stride; } }
        else { first = (int)blockIdx.x; stride = C.G; nsb = (N_SB - first + stride - 1) / stride; }
        if (nsb > 0) { SbPre pre; sb_prefetch(pre, proj, first, C.wid, C.lane);
            for (int i = 0; i < nsb; ++i) { const int u = first + i * stride;
                sb_unit(proj, obuf, (LAS bf16_t*)(C.lds + C.wid * 15360), u, i + 1 < nsb ? u + stride : -1, pre, C.wid, C.lane); } }
    }
    __syncthreads();
    if (C.tid == 0) { unsigned sp = 0u; while (xb_ld(memf) < (unsigned)N_MEMU) { __builtin_amdgcn_s_sleep(2); if (++sp > (1u << 24)) break; }
        __builtin_amdgcn_fence(__ATOMIC_ACQUIRE, "agent"); }
    __syncthreads();
    int ca_pair = -1;
    for (int u = C.vcu; u < N_CA; u += C.G) { const int lo8 = u & 255, pair = lo8 >> 2, qb = (lo8 & 3) * 4 + (u >> 8), hd = pair & 3, b = pair >> 2;
        if (!(pflags & 4)) ca_unit(C, proj, kvm, in_ptr(13), in_ptr(14), obuf, b, hd, qb, pair != ca_pair); ca_pair = pair; }
}
DI void p3_norm(const Ctx& C) {
    bf16_t* obuf = (bf16_t*)(C.ws + WS_O); const bf16_t* proj = (const bf16_t*)(C.ws + WS_PROJ); const unsigned* hlp = (const unsigned*)(C.ws + WS_HLP); const float* seg = (const float*)(C.ws + WS_SEG);
    LAS float* carry = (LAS float*)C.lds;
    for (int L = C.vcu; L < 256; L += C.G) {
        const int b = L >> 4, chunk = L & 15;
        __syncthreads();
        if (C.tid < 256) { const int ch = C.tid; const float* sp = seg + ((size_t)b * 32 * 256 + ch) * 2; float h = 0.f;
#pragma unroll 8
            for (int sg = 0; sg < 2 * chunk; ++sg) { const f32x2 v = *(const f32x2*)(sp + (size_t)sg * 512); h = v.x * h + v.y; }
            carry[ch] = h; const f32x2 v = *(const f32x2*)(sp + (size_t)(2 * chunk) * 512); carry[256 + ch] = v.x * h + v.y; }
        __syncthreads();
        for (int rr = 0; rr < 32; rr += 4) {
            const int lane = C.lane; u32x4 sb[4], hp[4]; u32x2 gt[4], ca[4];
#pragma unroll
            for (int u = 0; u < 4; ++u) { const int tl = C.wid * 32 + rr + u; const size_t row = (size_t)b * SEQ + chunk * 256 + tl; const bf16_t* rp = obuf + row * DM;
                sb[u] = *(const u32x4*)(rp + 8 * lane); ca[u] = *(const u32x2*)(rp + 768 + 4 * lane);
                hp[u] = *(const u32x4*)(hlp + row * 256 + 4 * lane); gt[u] = *(const u32x2*)(proj + row * DIN + COL_GRG + 4 * lane); }
#pragma unroll
            for (int u = 0; u < 4; ++u) { const int tl = C.wid * 32 + rr + u; bf16_t* rp = obuf + ((size_t)b * SEQ + chunk * 256 + tl) * DM;
                float vs[8], vr[4], vc[4]; float s_sb = 0.f, s_ca = 0.f, s_rg = 0.f;
#pragma unroll
                for (int q = 0; q < 4; ++q) { vs[2 * q] = bflo(sb[u][q]); vs[2 * q + 1] = bfhi(sb[u][q]); s_sb += vs[2 * q] * vs[2 * q] + vs[2 * q + 1] * vs[2 * q + 1]; }
                const LAS float* cy = carry + (tl >> 7) * 256 + 4 * lane;
#pragma unroll
                for (int q = 0; q < 4; ++q) { const float h = bflo(hp[u][q]) + bfhi(hp[u][q]) * cy[q];
                    const float g = (q & 1) ? bfhi(gt[u][q >> 1]) : bflo(gt[u][q >> 1]); vr[q] = gelu_tanh(g) * h; s_rg += vr[q] * vr[q]; }
#pragma unroll
                for (int q = 0; q < 2; ++q) { vc[2 * q] = bflo(ca[u][q]); vc[2 * q + 1] = bfhi(ca[u][q]); s_ca += vc[2 * q] * vc[2 * q] + vc[2 * q + 1] * vc[2 * q + 1]; }
                s_sb = wave_sum(s_sb); s_ca = wave_sum(s_ca); s_rg = wave_sum(s_rg);
                const float i_sb = __builtin_amdgcn_rsqf(s_sb * (1.f / 512.f) + RMS_EPS), i_rg = __builtin_amdgcn_rsqf(s_rg * (1.f / 256.f) + RMS_EPS), i_ca = __builtin_amdgcn_rsqf(s_ca * (1.f / 256.f) + RMS_EPS);
                u32x4 w; w.x = pk2(vs[0] * i_sb, vs[1] * i_sb); w.y = pk2(vs[2] * i_sb, vs[3] * i_sb); w.z = pk2(vs[4] * i_sb, vs[5] * i_sb); w.w = pk2(vs[6] * i_sb, vs[7] * i_sb);
                *(u32x4*)(rp + 8 * lane) = w;
                u32x2 w2; w2.x = pk2(vr[0] * i_rg, vr[1] * i_rg); w2.y = pk2(vr[2] * i_rg, vr[3] * i_rg); *(u32x2*)(rp + 512 + 4 * lane) = w2;
                u32x2 w3; w3.x = pk2(vc[0] * i_ca, vc[1] * i_ca); w3.y = pk2(vc[2] * i_ca, vc[3] * i_ca); *(u32x2*)(rp + 768 + 4 * lane) = w3; }
        }
    }
}
DI void p5_router(const Ctx& C, const bool dry) {
    const float* x1 = C.out;
    unsigned char* X1Q = C.ws + WS_X1Q;
    unsigned* AOFF = (unsigned*)(C.ws + WS_AOFF); float* PRINV = (float*)(C.ws + WS_PRINV); unsigned* PPAIR = (unsigned*)(C.ws + WS_PPAIR); float* PGW = (float*)(C.ws + WS_PGW);
    const bf16_t* WRH = (const bf16_t*)(C.ws + WS_WRHI); const bf16_t* WRL = (const bf16_t*)(C.ws + WS_WRLO);
    unsigned* cnt = (unsigned*)(C.ws + WS_CTL) + CW_CNT;
    LAS float* lg = (LAS float*)C.lds;
    LAS int* sel_e = (LAS int*)(C.lds + 66560);
    LAS float* sel_w = (LAS float*)(C.lds + 66560 + 8192);
    LAS int* sel_r = (LAS int*)(C.lds + 66560 + 16384);
    LAS int* lcount = (LAS int*)(C.lds + 66560 + 24576);
    LAS int* lbase = (LAS int*)(C.lds + 66560 + 24576 + 256);
    LAS float* lbias = (LAS float*)(C.lds + 66560 + 24576 + 512);
    LAS float* lrinv = (LAS float*)(C.lds + 66560 + 24576 + 768);
    const int lane = C.lane, wid = C.wid, tid = C.tid;
    for (int L = C.vcu; L < 256; L += C.G) {
        if (tid < 64) { lcount[tid] = 0; lbias[tid] = in_ptr(21)[tid]; }
        const int tbase = L * 256 + wid * 32;
        f32x4 acc[2][4];
#pragma unroll
        for (int m = 0; m < 2; ++m)
#pragma unroll
            for (int n = 0; n < 4; ++n) acc[m][n] = (f32x4){0.f, 0.f, 0.f, 0.f};
        float ss[2] = {0.f, 0.f};
        const int kq = lane >> 4, l15 = lane & 15;
        LAS unsigned char* qt = C.lds + 93184 + wid * 4608;
        const float* xrow[2]; xrow[0] = x1 + (size_t)(tbase + l15) * DM + 4 * kq; xrow[1] = xrow[0] + (size_t)16 * DM;
        LAS unsigned char* wl = C.lds;
        const bf16_t* wsrc = ((tid >> 8) ? WRL : WRH) + (size_t)((tid >> 2) & 63) * DM + 8 * (tid & 3);
        const int wdst = (tid >> 8) * 5120 + ((tid >> 2) & 63) * 80 + 16 * (tid & 3);
        const int wfr = l15 * 80 + 16 * kq;
        f32x4 X0[2][2], X1[2][2], X2[2][2], X3[2][2]; u32x4 wr0, wr1;
#define P5_LDX(X, k0_) do { const int kk_ = (k0_) < DM ? (k0_) : 0; _Pragma("unroll") for (int m = 0; m < 2; ++m) { X[m][0] = *(const f32x4*)(xrow[m] + kk_); X[m][1] = *(const f32x4*)(xrow[m] + kk_ + 16); } } while (0)
#define P5_LDWG(R, k0_) do { const int kk_ = (k0_) < DM ? (k0_) : 0; R = *(const u32x4*)(wsrc + kk_); } while (0)
#define P5_STW(R, buf_) do { *(LAS u32x4*)(wl + (buf_) * 10240 + wdst) = R; } while (0)
#define P5_STEP(X, buf_, k0_) do { bf16x8 ahi[2], alo[2]; \
        _Pragma("unroll") for (int m = 0; m < 2; ++m) { const f32x4 v0 = X[m][0], v1 = X[m][1]; \
            ss[m] += (v0[0] * v0[0] + v0[1] * v0[1]) + (v0[2] * v0[2] + v0[3] * v0[3]) + (v1[0] * v1[0] + v1[1] * v1[1]) + (v1[2] * v1[2] + v1[3] * v1[3]); \
            { LAS unsigned* qp_ = (LAS unsigned*)(qt + (16 * m + l15) * 144 + ((k0_) & 96) + 4 * kq); qp_[0] = pk4_fp8(v0[0], v0[1], v0[2], v0[3]); qp_[4] = pk4_fp8(v1[0], v1[1], v1[2], v1[3]); } \
            u32x4 hh, ll; \
            hh.x = pk2(v0[0], v0[1]); hh.y = pk2(v0[2], v0[3]); hh.z = pk2(v1[0], v1[1]); hh.w = pk2(v1[2], v1[3]); \
            ll.x = pk2(v0[0] - bflo(hh.x), v0[1] - bfhi(hh.x)); ll.y = pk2(v0[2] - bflo(hh.y), v0[3] - bfhi(hh.y)); \
            ll.z = pk2(v1[0] - bflo(hh.z), v1[1] - bfhi(hh.z)); ll.w = pk2(v1[2] - bflo(hh.w), v1[3] - bfhi(hh.w)); \
            ahi[m] = __builtin_bit_cast(bf16x8, hh); alo[m] = __builtin_bit_cast(bf16x8, ll); } \
        _Pragma("unroll") for (int n = 0; n < 4; ++n) { const bf16x8 wh_ = *(const LAS bf16x8*)(wl + (buf_) * 10240 + n * 1280 + wfr), wl_ = *(const LAS bf16x8*)(wl + (buf_) * 10240 + 5120 + n * 1280 + wfr); \
            _Pragma("unroll") for (int m = 0; m < 2; ++m) { acc[m][n] = MFMA16(wh_, ahi[m], acc[m][n]); acc[m][n] = MFMA16(wh_, alo[m], acc[m][n]); acc[m][n] = MFMA16(wl_, ahi[m], acc[m][n]); } } } while (0)
#define P5_FENCE() asm volatile("" ::: "memory")
#define P5_SYNC() do { LDS_WAIT(); __builtin_amdgcn_s_barrier(); P5_FENCE(); } while (0)
        __syncthreads();
        P5_LDX(X0, 0); P5_LDX(X1, 32); P5_LDX(X2, 64); P5_LDWG(wr0, 0); P5_LDWG(wr1, 32); P5_FENCE();
        P5_STW(wr0, 0); P5_SYNC();
        for (int k0 = 0; k0 < DM; k0 += 128) {
            P5_LDX(X3, k0 + 96);  P5_LDWG(wr0, k0 + 64);  P5_FENCE(); P5_STEP(X0, 0, k0);      P5_STW(wr1, 1); P5_SYNC();
            P5_LDX(X0, k0 + 128); P5_LDWG(wr1, k0 + 96);  P5_FENCE(); P5_STEP(X1, 1, k0 + 32); P5_STW(wr0, 0); P5_SYNC();
            P5_LDX(X1, k0 + 160); P5_LDWG(wr0, k0 + 128); P5_FENCE(); P5_STEP(X2, 0, k0 + 64); P5_STW(wr1, 1); P5_SYNC();
            P5_LDX(X2, k0 + 192); P5_LDWG(wr1, k0 + 160); P5_FENCE(); P5_STEP(X3, 1, k0 + 96); P5_STW(wr0, 0); P5_SYNC();
#pragma unroll
            for (int i = 0; i < 4; ++i) { const int row = (lane >> 3) + 8 * i, chunk = lane & 7; const u32x4 qv = *(const LAS u32x4*)(qt + row * 144 + 16 * chunk);
                *(u32x4*)(X1Q + (size_t)(tbase + row) * DM + k0 + 16 * chunk) = qv; }
            LDS_WAIT(); P5_FENCE();
        }
        __syncthreads();
#undef P5_LDX
#undef P5_LDWG
#undef P5_STW
#undef P5_STEP
#undef P5_FENCE
#undef P5_SYNC
#pragma unroll
        for (int m = 0; m < 2; ++m) { float s = ss[m]; s += __shfl_xor(s, 16); s += __shfl_xor(s, 32); const float rinv = __builtin_amdgcn_rsqf(s * (1.f / DM) + RMS_EPS);
            const int tl = wid * 32 + 16 * m + l15; if (kq == 0) lrinv[tl] = rinv;
#pragma unroll
            for (int n = 0; n < 4; ++n)
#pragma unroll
                for (int q = 0; q < 4; ++q) lg[tl * 65 + 16 * n + 4 * kq + q] = acc[m][n][q] * rinv; }
        __syncthreads();
        { const int tk = tid >> 1, hf = tid & 1;
            LAS float* row = lg + tk * 65;
#pragma unroll 4
            for (int e = 32 * hf; e < 32 * hf + 32; ++e) { const float s_ = sigmoidf_(row[e]); row[e] = s_ + lbias[e]; }
            float gmy[4];
#pragma unroll
            for (int g = 0; g < 4; ++g) { float m1 = -3.0e38f, m2 = -3.0e38f;
                for (int j = 0; j < 8; ++j) { const float v = row[32 * hf + 8 * g + j]; if (v > m1) { m2 = m1; m1 = v; } else if (v > m2) m2 = v; }
                gmy[g] = m1 + m2; }
            float gs[8];
#pragma unroll
            for (int g = 0; g < 4; ++g) { const float o_ = __shfl_xor(gmy[g], 1); gs[g] = hf ? o_ : gmy[g]; gs[4 + g] = hf ? gmy[g] : o_; }
            unsigned gmask = 0u;
#pragma unroll
            for (int it = 0; it < 4; ++it) { float best = -3.0e38f; int bi = 0;
#pragma unroll
                for (int g = 0; g < 8; ++g) { const bool free_ = !((gmask >> g) & 1u); if (free_ && gs[g] > best) { best = gs[g]; bi = g; } }
                gmask |= 1u << bi; }
            unsigned long long chosen = 0ull; float wsum = 0.f;
#pragma nounroll
            for (int k = 0; k < 8; ++k) { float best = -3.0e38f; int be = 64;
#pragma nounroll
                for (int g = 4 * hf; g < 4 * hf + 4; ++g) { if (!((gmask >> g) & 1u)) continue;
                    for (int j = 0; j < 8; ++j) { const int e = 8 * g + j; if ((chosen >> e) & 1ull) continue; const float v = row[e]; if (v > best) { best = v; be = e; } } }
                const float ob = __shfl_xor(best, 1); const int oe = __shfl_xor(be, 1);
                if (ob > best || (ob == best && oe < be)) { best = ob; be = oe; }
                chosen |= 1ull << be;
                if (hf == 0) { const float w = best - lbias[be]; wsum += w; sel_e[tk * 8 + k] = be; sel_w[tk * 8 + k] = w;
                    sel_r[tk * 8 + k] = __hip_atomic_fetch_add(lcount + be, 1, __ATOMIC_RELAXED, __HIP_MEMORY_SCOPE_WORKGROUP); } }
            if (hf == 0) { const float sc = 2.5f / (wsum + 1e-20f);
                for (int k = 0; k < 8; ++k) sel_w[tk * 8 + k] *= sc; }
        }
        __syncthreads();
        if (tid < 64) lbase[tid] = dry ? 0 : (int)__hip_atomic_fetch_add(cnt + tid, (unsigned)lcount[tid], __ATOMIC_RELAXED, __HIP_MEMORY_SCOPE_AGENT);
        __syncthreads();
        if (tid < 256 && !dry) { const int tok = L * 256 + tid; const float rv = lrinv[tid];
            for (int k = 0; k < 8; ++k) { const int e = sel_e[tid * 8 + k]; const size_t idx = (size_t)e * CAP + lbase[e] + sel_r[tid * 8 + k];
                AOFF[idx] = (unsigned)tok * (unsigned)DM; PRINV[idx] = rv; PPAIR[idx] = (unsigned)(tok * 8 + k); PGW[idx] = sel_w[tid * 8 + k] * 8.f; }
            AOFF[(size_t)NEXP * CAP + tok] = (unsigned)tok * (unsigned)DM; PRINV[(size_t)NEXP * CAP + tok] = rv; PPAIR[(size_t)NEXP * CAP + tok] = (unsigned)tok; PGW[(size_t)NEXP * CAP + tok] = 8.f; }
        __syncthreads();
    }
}
DI void moe_prep(const Ctx& C, LAS int* toff, LAS int* lcnt) {
    unsigned* cnt = (unsigned*)(C.ws + WS_CTL) + CW_CNT;
    __syncthreads();
    if (C.tid < 65) lcnt[C.tid] = C.tid < 64 ? (int)__hip_atomic_load(cnt + C.tid, RLX_AGENT) : T_TOK;
    __syncthreads();
    if (C.tid < 64) { const int t_ = (lcnt[C.tid] + 255) >> 8; int inc = t_;
#pragma unroll
        for (int o = 1; o < 64; o <<= 1) { const int v = __shfl_up(inc, o); if (C.tid >= o) inc += v; }
        toff[C.tid] = inc - t_; if (C.tid == 63) { toff[64] = inc; toff[65] = inc + ((lcnt[64] + 255) >> 8); } }
    __syncthreads();
}
DI void moe_units(const Ctx& C, const LAS int* toff, const LAS int* lcnt, LAS int* desc, int rt_lo, int rt_hi, int shift, const bool grouped = true) {
    __syncthreads();
    if (C.tid < 64) {
        const int per = 1 << shift, full = grouped ? (rt_hi - rt_lo) / C.G : 0, i = C.tid; int rt, sub;
        if (i < full * per) { rt = rt_lo + (i >> shift) * C.G + C.vcu; sub = i & (per - 1); }
        else { const int L = (i - full * per) * C.G + C.vcu; rt = rt_lo + full * C.G + (L >> shift); sub = L & (per - 1); }
        int e = 0, tile = 0, nv = 0, r = -1;
        if (rt < rt_hi) { int lo = 0, hi = 64; while (lo < hi) { const int mid = (lo + hi + 1) >> 1; if (toff[mid] <= rt) lo = mid; else hi = mid - 1; }
            e = lo; tile = rt - toff[lo]; const int rem = lcnt[lo] - tile * 256; nv = rem < 256 ? rem : 256; r = rt; }
        desc[4 * C.tid] = r; desc[4 * C.tid + 1] = e | (sub << 8); desc[4 * C.tid + 2] = tile; desc[4 * C.tid + 3] = nv; }
    __syncthreads();
}
DI void p8_combine(const Ctx& C, const bool dry) {
    const unsigned char* y8 = C.ws + WS_Y8; const unsigned char* y8s = C.ws + WS_Y8S; float* out = C.out;
    const int gw = C.vcu * 8 + C.wid, NGW = C.G * 8, lane = C.lane;
    for (int tok = gw; tok < T_TOK; tok += NGW) {
        float a[16];
        float* op = out + (size_t)tok * DM + 4 * lane;
#pragma unroll
        for (int q = 0; q < 4; ++q) { const f32x4 v = *(const f32x4*)(op + 256 * q); a[4 * q] = v[0]; a[4 * q + 1] = v[1]; a[4 * q + 2] = v[2]; a[4 * q + 3] = v[3]; }
        unsigned w[9][4];
#pragma unroll
        for (int k = 0; k < 9; ++k) { const unsigned* rp = (const unsigned*)(k < 8 ? y8 + ((size_t)tok * 8 + k) * DM : y8s + (size_t)tok * DM) + lane;
#pragma unroll
            for (int q = 0; q < 4; ++q) w[k][q] = __builtin_nontemporal_load(rp + 64 * q); }
        float s[16];
#pragma unroll
        for (int i = 0; i < 16; ++i) s[i] = 0.f;
#pragma unroll
        for (int k = 0; k < 9; ++k)
#pragma unroll
            for (int q = 0; q < 4; ++q) { const f32x2 lo = __builtin_amdgcn_cvt_pk_f32_fp8((int)w[k][q], false), hi = __builtin_amdgcn_cvt_pk_f32_fp8((int)w[k][q], true);
                s[4 * q] += lo[0]; s[4 * q + 1] += lo[1]; s[4 * q + 2] += hi[0]; s[4 * q + 3] += hi[1]; }
#pragma unroll
        for (int q = 0; q < 4; ++q) { f32x4 v; v[0] = a[4 * q] + 0.125f * s[4 * q]; v[1] = a[4 * q + 1] + 0.125f * s[4 * q + 1]; v[2] = a[4 * q + 2] + 0.125f * s[4 * q + 2]; v[3] = a[4 * q + 3] + 0.125f * s[4 * q + 3]; if (!dry || v[0] == 1.2345678e30f) __builtin_nontemporal_store(v, (f32x4*)(op + 256 * q)); }
    }
}

__global__ void __launch_bounds__(512, 2) mk_fwd(Args args) {
    extern __shared__ __attribute__((aligned(16))) unsigned char lds_raw[];
    Ctx C;
    C.lds_generic = lds_raw; C.lds = (LAS unsigned char*)lds_raw;
    C.tid = threadIdx.x; C.lane = C.tid & 63; C.wid = __builtin_amdgcn_readfirstlane(C.tid >> 6);
    C.G = gridDim.x; { const int bx = blockIdx.x; C.vcu = (C.G % 8 == 0) ? (bx % 8) * (C.G / 8) + bx / 8 : bx; }
    C.out = args.out; C.ws = args.ws; C.xcd = (int)(xb_xcc_id() & 7u);
    for (int u = C.tid; u < (LDS_BYTES - LDSCTL_OFF) / 4; u += 512) ((LAS unsigned*)(C.lds + LDSCTL_OFF))[u] = 0u;
    __syncthreads();
    const int lo = args.ph_lo, hi = args.ph_hi; const int pflags = args.flags; const bool skipe = (pflags & 1) != 0;
    unsigned* ctl = (unsigned*)(C.ws + WS_CTL);
    XcdBarrier bar; bar.bar = ctl + CW_BAR; bar.x = 0; bar.st = nullptr;
    if (hi - lo > 1) bar = xcd_barrier_post(ctl + CW_BAR, (volatile LAS unsigned*)(C.lds + MISC_OFF) + 8);
    constexpr int CW_GRP = 12400, CW_GMASK = 13000;
    const unsigned vgrp = blockIdx.x & 7u;
    if (hi - lo > 1 && C.tid == 0) (void)__hip_atomic_fetch_or(ctl + CW_GMASK + vgrp, 1u << (xb_xcc_id() & 15u), __ATOMIC_RELAXED, __HIP_MEMORY_SCOPE_AGENT);
    bool grp_ok = false, grp_coloc = false;
#ifndef MK_PHASE_MASK
#define MK_PHASE_MASK 0x1ff
#endif
#define IN(k) (((MK_PHASE_MASK >> (k)) & 1) && lo <= (k) && (k) < hi)
#define SEAM(k) do { if (IN(k) && IN((k) + 1)) xcd_barrier(bar); } while (0)
    LAS int* toff = (LAS int*)(C.lds + TOFF_OFF); LAS int* lcnt = (LAS int*)(C.lds + LCNT_OFF); LAS unsigned* tab = (LAS unsigned*)(C.lds + TAB_OFF); LAS int* udesc = (LAS int*)(C.lds + UDESC_OFF);

    if (IN(0)) { p0_prologue(C); SEAM(0);
        if (IN(1) && C.G == 256) {     const unsigned m_ = (unsigned)__builtin_amdgcn_readfirstlane((int)xb_ld(ctl + CW_GMASK + vgrp)); grp_ok = true; grp_coloc = __builtin_popcount(m_) == 1; } }
#define GSEAM(k) do { if (IN(k) && IN((k) + 1)) { if (grp_ok) grp_barrier(ctl + CW_GRP + 64 * vgrp, (unsigned)C.G / 8u, grp_coloc); else xcd_barrier(bar); } } while (0)
    if (IN(1)) {
        { pg8::SchedStatic S; S.init(T_TOK, DIN, DM, C.G, (int)blockIdx.x, C.ws + WS_W1T, (const float*)(C.ws + WS_RINV1));
          pg8::EpiRowScaleBf16 E{(bf16_t*)(C.ws + WS_PROJ), DIN, true, 0.125f * 1.4426950408889634f, 2};
          pg8::gemm_phase<false>(C.lds, tab, (const char*)(C.ws + WS_XB), DM * 2, S, E, (unsigned)C.xcd * STAG_P1, skipe); }
        if (grp_ok && C.G == 256) GSEAM(1); else SEAM(1);
    }
    const bool g2 = grp_ok && C.G == 256;
    if (IN(2)) { p2_mixers(C, pflags, tab, g2); if (g2) GSEAM(2); else SEAM(2); }
    if (IN(3)) { p3_norm(C); GSEAM(3); }
    if (IN(4)) {
        pg8::SchedStatic S; S.init(T_TOK, DM, DM, C.G, (int)blockIdx.x, C.ws + WS_W2T, nullptr);
        pg8::EpiX1 E{in_ptr(0), C.out};
        pg8::gemm_phase<false>(C.lds, tab, (const char*)(C.ws + WS_O), DM * 2, S, E, (unsigned)C.xcd * STAG_P4, skipe);
        GSEAM(4);
    }
    if (IN(5)) { p5_router(C, (pflags & 32) != 0); SEAM(5); }
    if (IN(6)) {
        moe_prep(C, toff, lcnt);
        moe_units(C, toff, lcnt, udesc, 0, __builtin_amdgcn_readfirstlane(toff[65]), 1, false);
        pg8::SchedGU S{udesc, (const unsigned*)(C.ws + WS_AOFF), (const unsigned*)(C.ws + WS_PRINV), (const unsigned*)(C.ws + WS_CTL) + 1, (const char*)(C.ws + WS_WGU)};
        pg8::EpiGU E{C.ws + WS_HID};
        pg8::gemm_phase<true>(C.lds, tab, (const char*)(C.ws + WS_X1Q), DM, S, E, (unsigned)C.xcd * STAG_P6, skipe);
        SEAM(6);
    }
    if (IN(7)) {
        moe_prep(C, toff, lcnt);
        moe_units(C, toff, lcnt, udesc, 0, __builtin_amdgcn_readfirstlane(toff[65]), 2);
        pg8::SchedDown S{udesc, (const unsigned*)(C.ws + WS_PPAIR), (const unsigned*)(C.ws + WS_PGW), (const unsigned*)(C.ws + WS_CTL) + 1, (const char*)(C.ws + WS_WD)};
        pg8::EpiDownR E{C.ws + WS_Y8, C.ws + WS_Y8S};
        pg8::gemm_phase<true>(C.lds, tab, (const char*)(C.ws + WS_HID), DEXP, S, E, (unsigned)C.xcd * STAG_P7, skipe);
        SEAM(7);
    }
    if (IN(8)) { p8_combine(C, (pflags & 16) != 0); }
#undef IN
#undef SEAM
#undef GSEAM
}

extern "C" void kernel_launch(void* const* d_in, const int* in_sizes, int n_in, void* d_out, int out_size, void* d_ws, size_t ws_size, hipStream_t stream) {
    static int grid = 0;
    if (grid == 0) {
        if (n_in != 28 || out_size != T_TOK * DM || ws_size < WS_END) { fprintf(stderr, "kernel_launch: unexpected shapes (n_in %d out %d ws %zu)\n", n_in, out_size, ws_size); grid = -1; return; }
        int dev = 0, cus = 0, per_cu = 0;
        if (hipGetDevice(&dev) != hipSuccess || hipDeviceGetAttribute(&cus, hipDeviceAttributeMultiprocessorCount, dev) != hipSuccess) { grid = -1; return; }
        if (hipFuncSetAttribute((const void*)mk_fwd, hipFuncAttributeMaxDynamicSharedMemorySize, LDS_BYTES) != hipSuccess) { fprintf(stderr, "kernel_launch: hipFuncSetAttribute failed\n"); grid = -1; return; }
        if (hipOccupancyMaxActiveBlocksPerMultiprocessor(&per_cu, (const void*)mk_fwd, 512, LDS_BYTES) != hipSuccess || per_cu < 1) fprintf(stderr, "kernel_launch: occupancy query says %d\n", per_cu);
        (void)hipGetLastError();
        grid = cus;
    }
    if (grid < 0) return;
    (void)hipMemsetAsync((char*)d_ws + WS_CTL, 0, CTL_ZERO_BYTES, stream);
    Args a{};
    for (int i = 0; i < 28; ++i) a.in[i] = (const float*)d_in[i];
    a.out = (float*)d_out; a.ws = (unsigned char*)d_ws;
    if (MK_N_LAUNCHES == 1) { a.ph_lo = 0; a.ph_hi = NPHASE; hipLaunchKernelGGL(mk_fwd, dim3(grid), dim3(512), LDS_BYTES, stream, a); }
    else { for (int p = 0; p < NPHASE; ++p) { a.ph_lo = p; a.ph_hi = p + 1; const int reps = (p == MK_REPEAT) ? 1 + MK_REPEAT_N : 1;
            for (int q = 0; q < reps; ++q) { a.flags = (q > 0) ? MK_REPEAT_FLAGS : 0; hipLaunchKernelGGL(mk_fwd, dim3(grid), dim3(512), LDS_BYTES, stream, a); } a.flags = 0; } }
}
```
